# Optimizing an MI355X kernel written in HIP

```python
import math
import jax, jax.numpy as jnp
from jax import lax
import numpy as np

D_MODEL = 1024
BATCH = 4
SEQ = 8192
DEPTH = 2

GRID_W = 64
CTX_LEN = 256
HEAD_DIM = 64
ROPE_BASE = 10000.0
NORM_EPS = 1e-6
NEG_INF = -1e30
F32 = jnp.float32

A_HEADS = 4
A_KV_HEADS = 2
A_GROUP = A_HEADS // A_KV_HEADS
A_WINDOW = 128
A_BLOCK = 128
B_HEADS = 4
B_QK_DIM = 64
B_V_DIM = 2 * B_QK_DIM
B_BLOCK = 128
C_HEADS = 4
C_QK_DIM = 32
C_V_DIM = 2 * C_QK_DIM
C_CHUNK = 128

A_Q = A_HEADS * HEAD_DIM
A_KV = A_KV_HEADS * HEAD_DIM
B_QK = B_HEADS * 2 * B_QK_DIM
B_V = B_HEADS * B_V_DIM
C_QK = C_HEADS * C_QK_DIM
C_V = C_HEADS * C_V_DIM
SPLIT_SIZES = (A_Q, A_KV, A_KV, B_QK, B_QK, B_V, C_QK, C_QK, C_V, C_V)
IN_WIDTH = sum(SPLIT_SIZES)
SPLIT_POINTS = tuple(int(s) for s in np.cumsum(SPLIT_SIZES)[:-1])
MIX_WIDTH = A_Q + B_V + C_V

D_FF = 2816
CONV_W = 3
N_MOD = 6

kernel_name = "hybrid_parallel_groups_diffusion_trunk"


def rms_norm(x, g):
    xf = x.astype(F32)
    y = xf * lax.rsqrt(jnp.mean(xf * xf, axis=-1, keepdims=True) + NORM_EPS)
    return (y * g.astype(F32)).astype(x.dtype)


def modulate(h, shift, scale):
    return h * (1.0 + scale) + shift


def axial_rope_tables(n_tok, dim):
    n_rows = n_tok // GRID_W
    rows = jnp.repeat(jnp.arange(n_rows, dtype=F32), GRID_W)
    cols = jnp.tile(jnp.arange(GRID_W, dtype=F32), n_rows)
    n_freq = dim // 4
    inv = ROPE_BASE ** (-jnp.arange(n_freq, dtype=F32) / n_freq)
    ang = jnp.concatenate([rows[:, None] * inv, cols[:, None] * inv], axis=-1)
    return jnp.cos(ang), jnp.sin(ang)


def apply_rope(x, cos, sin):
    half = x.shape[-1] // 2
    shp = cos.shape[:1] + (1,) * (x.ndim - 3) + cos.shape[1:]
    c = cos.reshape(shp).astype(x.dtype)
    s = sin.reshape(shp).astype(x.dtype)
    x1, x2 = x[..., :half], x[..., half:]
    return jnp.concatenate([x1 * c - x2 * s, x1 * s + x2 * c], axis=-1)


def split_projection(p):
    bsz, n = p.shape[:2]
    qa, ka, va, qb, kb, vb, qr, kr, vr, gr = jnp.split(p, SPLIT_POINTS, axis=-1)
    qa = qa.reshape(bsz, n, A_HEADS, HEAD_DIM)
    ka = ka.reshape(bsz, n, A_KV_HEADS, HEAD_DIM)
    va = va.reshape(bsz, n, A_KV_HEADS, HEAD_DIM)
    qb = qb.reshape(bsz, n, B_HEADS, 2, B_QK_DIM)
    kb = kb.reshape(bsz, n, B_HEADS, 2, B_QK_DIM)
    vb = vb.reshape(bsz, n, B_HEADS, B_V_DIM)
    qr = qr.reshape(bsz, n, C_HEADS, C_QK_DIM)
    kr = kr.reshape(bsz, n, C_HEADS, C_QK_DIM) * (C_QK_DIM ** -0.5)
    vr = vr.reshape(bsz, n, C_HEADS, C_V_DIM)
    return qa, ka, va, qb, kb, vb, qr, kr, vr, gr


def softmax_with_sink(scores, sink):
    m = jnp.maximum(jnp.max(scores, axis=-1, keepdims=True), sink)
    e = jnp.exp(scores - m)
    return e / (jnp.sum(e, axis=-1, keepdims=True) + jnp.exp(sink - m))


def window_gqa_latent(q, k, v, kc, vc, sink):
    bsz, n, _, d = q.shape
    nb = n // A_BLOCK
    scale = d ** -0.5
    qb = q.reshape(bsz, nb, A_BLOCK, A_KV_HEADS, A_GROUP, d)
    pad = ((0, 0), (A_BLOCK, A_BLOCK), (0, 0), (0, 0))
    kp = jnp.pad(k, pad).reshape(bsz, nb + 2, A_BLOCK, A_KV_HEADS, d)
    vp = jnp.pad(v, pad).reshape(bsz, nb + 2, A_BLOCK, A_KV_HEADS, d)
    kband = jnp.concatenate([kp[:, :-2], kp[:, 1:-1], kp[:, 2:]], axis=2)
    vband = jnp.concatenate([vp[:, :-2], vp[:, 1:-1], vp[:, 2:]], axis=2)
    s_loc = jnp.einsum('bnqhgd,bnkhd->bhgnqk', qb, kband).astype(F32) * scale
    s_ctx = jnp.einsum('bnqhgd,blhd->bhgnql', qb, kc).astype(F32) * scale
    qi = jnp.arange(A_BLOCK)[:, None]
    kj = jnp.arange(3 * A_BLOCK)[None, :]
    rel = kj - A_BLOCK - qi
    kpos = jnp.arange(nb)[:, None, None] * A_BLOCK - A_BLOCK + kj
    valid = (jnp.abs(rel) <= A_WINDOW)[None] & (kpos >= 0) & (kpos < n)
    s_loc = jnp.where(valid, s_loc, NEG_INF)
    scores = jnp.concatenate([s_loc, s_ctx], axis=-1)
    sink_b = sink.astype(F32).reshape(A_KV_HEADS, A_GROUP)[None, :, :, None, None, None]
    p = softmax_with_sink(scores, sink_b).astype(v.dtype)
    p_loc, p_ctx = p[..., :3 * A_BLOCK], p[..., 3 * A_BLOCK:]
    out = (jnp.einsum('bhgnqk,bnkhd->bnqhgd', p_loc, vband)
           + jnp.einsum('bhgnql,blhd->bnqhgd', p_ctx, vc))
    return out.reshape(bsz, n, A_Q)


def gqa_context(q, k, v, sink):
    bsz, n, _, d = q.shape
    qg = q.reshape(bsz, n, A_KV_HEADS, A_GROUP, d)
    s = jnp.einsum('blhgd,bmhd->bhglm', qg, k).astype(F32) * (d ** -0.5)
    sink_b = sink.astype(F32).reshape(A_KV_HEADS, A_GROUP)[None, :, :, None, None]
    p = softmax_with_sink(s, sink_b).astype(v.dtype)
    return jnp.einsum('bhglm,bmhd->blhgd', p, v).reshape(bsz, n, A_Q)


def diff_attend(q, k, v, lam):
    s = jnp.einsum('bqhcd,bkhcd->bhcqk', q, k).astype(F32) * (B_QK_DIM ** -0.5)
    p = jax.nn.softmax(s, axis=-1)
    w = p[:, :, 0] - lam * p[:, :, 1]
    return jnp.einsum('bhqk,bkhd->bqhd', w.astype(v.dtype), v)


def diff_attention_latent(q, k, v, kc, vc, lam):
    bsz, n = q.shape[:2]
    k_all = jnp.concatenate([kc, k], axis=1)
    v_all = jnp.concatenate([vc, v], axis=1)
    qblocks = jnp.moveaxis(q.reshape(bsz, n // B_BLOCK, B_BLOCK, B_HEADS, 2, B_QK_DIM), 1, 0)
    out = lax.map(lambda qb: diff_attend(qb, k_all, v_all, lam), qblocks)
    return jnp.moveaxis(out, 0, 1).reshape(bsz, n, B_HEADS, B_V_DIM)


def diff_head_norm(o, g, lam_init):
    of = o.astype(F32)
    y = of * lax.rsqrt(jnp.mean(of * of, axis=-1, keepdims=True) + NORM_EPS)
    y = y * g.astype(F32) * (1.0 - lam_init)
    return y.reshape(o.shape[0], o.shape[1], B_V).astype(o.dtype)


def retention_chunked(q, k, v, log_gamma, state0, include_diag):
    bsz, nh, n, dk = q.shape
    dv = v.shape[-1]
    nc = n // C_CHUNK
    qc = q.astype(F32).reshape(bsz, nh, nc, C_CHUNK, dk)
    kc = k.astype(F32).reshape(bsz, nh, nc, C_CHUNK, dk)
    vc = v.astype(F32).reshape(bsz, nh, nc, C_CHUNK, dv)
    idx = jnp.arange(C_CHUNK, dtype=F32)
    lg = log_gamma.astype(F32)[:, None]
    diff = idx[:, None] - idx[None, :]
    mask = (diff >= 0) if include_diag else (diff > 0)
    decay = jnp.where(mask, jnp.exp(lg[:, :, None] * jnp.maximum(diff, 0.0)), 0.0)
    att = jnp.einsum('bhncd,bhnjd->bhncj', qc, kc) * decay[None, :, None]
    intra = jnp.einsum('bhncj,bhnje->bhnce', att, vc)
    q_decay = jnp.exp(lg * (idx + 1.0))
    k_decay = jnp.exp(lg * (C_CHUNK - 1.0 - idx))
    chunk_kv = jnp.einsum('bhnjd,bhnje->bhnde', kc * k_decay[None, :, None, :, None], vc)
    chunk_decay = jnp.exp(lg * C_CHUNK)[None, :, :, None]

    def step(state, kv):
        return chunk_decay * state + kv, state

    _, prev = lax.scan(step, state0, jnp.moveaxis(chunk_kv, 2, 0))
    prev = jnp.moveaxis(prev, 0, 2)
    cross = jnp.einsum('bhncd,bhnde->bhnce', qc * q_decay[None, :, None, :, None], prev)
    return (intra + cross).reshape(bsz, nh, n, dv)


def bidir_retention(q, k, v, lg_f, lg_b, s_f, s_b):
    y_f = retention_chunked(q, k, v, lg_f, s_f, True)
    flip = lambda t: jnp.flip(t, axis=2)
    y_b = flip(retention_chunked(flip(q), flip(k), flip(v), lg_b, s_b, False))
    return y_f + y_b


def context_final_states(k, v, lg_f, lg_b):
    n = k.shape[2]
    idx = jnp.arange(n, dtype=F32)
    wf = jnp.exp(lg_f[:, None] * (n - 1.0 - idx))
    wb = jnp.exp(lg_b[:, None] * idx)
    kf = k.astype(F32)
    vf = v.astype(F32)
    s_f = jnp.einsum('bhld,bhle->bhde', kf * wf[None, :, :, None], vf)
    s_b = jnp.einsum('bhld,bhle->bhde', kf * wb[None, :, :, None], vf)
    return s_f, s_b


def retention_out(y, gate):
    yc = y - jnp.mean(y, axis=-1, keepdims=True)
    yn = yc * lax.rsqrt(jnp.mean(yc * yc, axis=-1, keepdims=True) + NORM_EPS)
    yn = jnp.swapaxes(yn, 1, 2).reshape(gate.shape)
    return (jax.nn.silu(gate.astype(F32)) * yn).astype(gate.dtype)


def dwconv3(u, w, b):
    up = jnp.pad(u, ((0, 0), (1, 1), (0, 0)))
    return up[:, :-2] * w[0] + up[:, 1:-1] * w[1] + up[:, 2:] * w[2] + b


def gated_conv_ffn(h, w_up, conv_w, conv_b, w_down):
    u = dwconv3(h @ w_up, conv_w, conv_b)
    val, gate = jnp.split(u, 2, axis=-1)
    return (jax.nn.silu(gate) * val) @ w_down


def to_bhnd(t):
    return jnp.swapaxes(t, 1, 2)


def setup_inputs(seed: int = 0) -> dict:
    key = jax.random.key(seed)
    ks = jax.random.split(key, 20)
    nrm = lambda k, shape, s: jax.random.normal(k, shape, F32) * s
    gam = 1.0 - 2.0 ** (-5.0 - np.arange(C_HEADS))
    logit0 = jnp.asarray(np.log(gam / (1.0 - gam)).astype(np.float32))
    return {
        "x": nrm(ks[0], (BATCH, SEQ, D_MODEL), 1.0),
        "c": nrm(ks[1], (BATCH, D_MODEL), 1.0),
        "ctx": nrm(ks[2], (BATCH, CTX_LEN, D_MODEL), 1.0),
        "c_ctx": nrm(ks[3], (D_MODEL,), 1.0),
        "w_mod": nrm(ks[4], (DEPTH, D_MODEL, N_MOD * D_MODEL), D_MODEL ** -0.5),
        "b_mod": nrm(ks[5], (DEPTH, N_MOD * D_MODEL), 0.01),
        "norm1_g": 1.0 + nrm(ks[6], (DEPTH, D_MODEL), 0.01),
        "norm2_g": 1.0 + nrm(ks[7], (DEPTH, D_MODEL), 0.01),
        "w_in": nrm(ks[8], (DEPTH, D_MODEL, IN_WIDTH), D_MODEL ** -0.5),
        "w_out": nrm(ks[9], (DEPTH, MIX_WIDTH, D_MODEL), MIX_WIDTH ** -0.5),
        "attn_sink": nrm(ks[10], (DEPTH, A_HEADS), 0.5),
        "diff_lambda": nrm(ks[11], (DEPTH, 4, B_QK_DIM), 0.1),
        "diff_subln_g": 1.0 + nrm(ks[12], (DEPTH, B_V_DIM), 0.01),
        "ret_decay_logit": logit0[None, None, :] + nrm(ks[13], (DEPTH, 2, C_HEADS), 0.01),
        "w_up": nrm(ks[14], (DEPTH, D_MODEL, 2 * D_FF), D_MODEL ** -0.5),
        "conv_w": nrm(ks[15], (DEPTH, CONV_W, 2 * D_FF), CONV_W ** -0.5),
        "conv_b": nrm(ks[16], (DEPTH, 2 * D_FF), 0.01),
        "w_down": nrm(ks[17], (DEPTH, D_FF, D_MODEL), D_FF ** -0.5),
        "final_g": 1.0 + nrm(ks[18], (D_MODEL,), 0.01),
    }


def reference(x, c, ctx, c_ctx, w_mod, b_mod, norm1_g, norm2_g, w_in, w_out, attn_sink,
              diff_lambda, diff_subln_g, ret_decay_logit, w_up, conv_w, conv_b, w_down, final_g):
    bsz, n_lat = x.shape[0], x.shape[1]
    cos_h, sin_h = axial_rope_tables(n_lat, HEAD_DIM)
    cos_r, sin_r = axial_rope_tables(n_lat, C_QK_DIM)
    zero_state = jnp.zeros((bsz, C_HEADS, C_QK_DIM, C_V_DIM), F32)
    xc = ctx
    for l in range(DEPTH):
        is_last = l == DEPTH - 1
        lam_init = 0.8 - 0.6 * math.exp(-0.3 * l)
        mod = jax.nn.silu(c) @ w_mod[l] + b_mod[l]
        mod_c = jax.nn.silu(c_ctx) @ w_mod[l] + b_mod[l]
        sh1, sc1, g1, sh2, sc2, g2 = [m[:, None, :] for m in jnp.split(mod, N_MOD, axis=-1)]
        csh1, csc1, cg1, csh2, csc2, cg2 = jnp.split(mod_c, N_MOD, axis=-1)

        h = modulate(rms_norm(x, norm1_g[l]), sh1, sc1)
        hc = modulate(rms_norm(xc, norm1_g[l]), csh1, csc1)
        qa, ka, va, qb, kb, vb, qr, kr, vr, gr = split_projection(h @ w_in[l])
        qa_c, ka_c, va_c, qb_c, kb_c, vb_c, qr_c, kr_c, vr_c, gr_c = split_projection(hc @ w_in[l])

        qa, ka = apply_rope(qa, cos_h, sin_h), apply_rope(ka, cos_h, sin_h)
        qb, kb = apply_rope(qb, cos_h, sin_h), apply_rope(kb, cos_h, sin_h)
        qr, kr = apply_rope(qr, cos_r, sin_r), apply_rope(kr, cos_r, sin_r)

        lq1, lk1, lq2, lk2 = diff_lambda[l].astype(F32)
        lam = jnp.exp(jnp.sum(lq1 * lk1)) - jnp.exp(jnp.sum(lq2 * lk2)) + lam_init
        log_g = jax.nn.log_sigmoid(ret_decay_logit[l].astype(F32))
        lg_f, lg_b = log_g[0], log_g[1]
        qr_c, kr_c, vr_c = to_bhnd(qr_c), to_bhnd(kr_c), to_bhnd(vr_c)
        s_f, s_b = context_final_states(kr_c, vr_c, lg_f, lg_b)

        a_out = window_gqa_latent(qa, ka, va, ka_c, va_c, attn_sink[l])
        b_out = diff_head_norm(diff_attention_latent(qb, kb, vb, kb_c, vb_c, lam),
                               diff_subln_g[l], lam_init)
        c_out = retention_out(bidir_retention(to_bhnd(qr), to_bhnd(kr), to_bhnd(vr),
                                              lg_f, lg_b, s_f, s_b), gr)
        mix = jnp.concatenate([a_out, b_out.astype(a_out.dtype), c_out.astype(a_out.dtype)], axis=-1)
        x_new = x + g1 * (mix @ w_out[l])
        h2 = modulate(rms_norm(x_new, norm2_g[l]), sh2, sc2)
        x_new = x_new + g2 * gated_conv_ffn(h2, w_up[l], conv_w[l], conv_b[l], w_down[l])

        if not is_last:
            a_c = gqa_context(qa_c, ka_c, va_c, attn_sink[l])
            b_c = diff_head_norm(diff_attend(qb_c, kb_c, vb_c, lam), diff_subln_g[l], lam_init)
            c_c = retention_out(bidir_retention(qr_c, kr_c, vr_c, lg_f, lg_b, zero_state, zero_state),
                                gr_c)
            mix_c = jnp.concatenate([a_c, b_c.astype(a_c.dtype), c_c.astype(a_c.dtype)], axis=-1)
            xc = xc + cg1 * (mix_c @ w_out[l])
            hc2 = modulate(rms_norm(xc, norm2_g[l]), csh2, csc2)
            xc = xc + cg2 * gated_conv_ffn(hc2, w_up[l], conv_w[l], conv_b[l], w_down[l])
        x = x_new
    return rms_norm(x, final_g)
```

```cpp
#include <hip/hip_runtime.h>
#include <hip/hip_cooperative_groups.h>
#include <cstdio>
#include <cstdint>
namespace cg = cooperative_groups;
__device__ __forceinline__ int ltid() { int t = threadIdx.x; asm volatile("" : "+v"(t)); return t; }
__device__ __forceinline__ int lbid() { int t = blockIdx.x; asm volatile("" : "+s"(t)); return t; }
namespace pg8 {
#define PG8_LAS __attribute__((address_space(3)))
typedef unsigned short bf16_t;
typedef short bf16x8 __attribute__((ext_vector_type(8)));
typedef float f32x4 __attribute__((ext_vector_type(4)));
typedef unsigned u32x4 __attribute__((ext_vector_type(4)));
constexpr int BM = 256, BK = 64, HALF = 128, HTB = HALF * BK * 2  , STAGE_BYTES = 8 * HTB, NXCD = 8, WGM = 8;

__host__ __device__ __forceinline__ int lds_byte(int r, int c) { const int st = (r >> 4) * 2 + (c >> 5), rr = r & 15, cc = c & 31, ob = rr * 64 + cc * 2; return st * 1024 + (ob ^ (((ob >> 9) & 1) << 5)); }
__host__ __device__ __forceinline__ void stage_rc(int b, int& R, int& C) { const int st = b / 1024, sb = b % 1024, swz = sb ^ (((sb >> 9) & 1) << 5); R = (st >> 1) * 16 + swz / 64; C = (st & 1) * 32 + (swz % 64) / 2; }
__host__ __device__ __forceinline__ int perm32(int rho) { const int n = rho >> 4, i = rho & 15; return 8 * (i >> 2) + 4 * n + (i & 3); }

struct Unit { int pm, pn; };
struct Gemm { const bf16_t* A; const bf16_t* Bt; int M, N, K; };

struct StaticOrder {
    int nM, nN, nwg, G, c;
    __host__ __device__ void init(int M, int N, int G_, int c_) { nM = M / BM; nN = N / BM; nwg = nM * nN; G = G_; c = c_; }
    __host__ __device__ bool next(int i, Unit& u) const {
        const long L = (long)i * G + c; if (L >= nwg) return false;
        int wgid = (int)L; { const int q = nwg / NXCD, r = nwg % NXCD, xcd = wgid % NXCD, off = wgid / NXCD; wgid = (xcd < r ? xcd * (q + 1) : r * (q + 1) + (xcd - r) * q) + off; }
        const int nig = WGM * nN, gid = wgid / nig, fm = gid * WGM, gsz = (nM - fm) < WGM ? (nM - fm) : WGM;
        u.pm = fm + ((wgid % nig) % gsz); u.pn = (wgid % nig) / gsz; return true;
    }
    __device__ __forceinline__ void a_ready(const Unit&) const {}
    __device__ __forceinline__ void done(const Unit&) const {}
};

__device__ __forceinline__ unsigned cvt_pk_bf16(float lo, float hi) { unsigned r; asm volatile("v_cvt_pk_bf16_f32 %0, %1, %2" : "=v"(r) : "v"(lo), "v"(hi)); return r; }
typedef float f32x2 __attribute__((ext_vector_type(2)));
template <class Epi, class Sched, bool ALIGN_EPI = false, bool SP2 = false>
__device__ __forceinline__ void gemm_phase(PG8_LAS unsigned char* lds, const Gemm g, const Sched& S, const Epi& E) {
    const int tid = ltid(), wid = __builtin_amdgcn_readfirstlane(tid >> 6), lane = tid & 63, wr = wid >> 2, wc = wid & 3, fr = lane & 15, fq = lane >> 4;
    const int K = g.K, nt = K / BK;
    unsigned voffA[2], voffB[2];
#pragma unroll
    for (int i = 0; i < 2; ++i) { int R, C; stage_rc(tid * 16 + i * 8192, R, C); const int Rb = Epi::PERM ? ((R & ~31) + perm32(R & 31)) : R;
        const int Ra = Epi::AREMAP ? ((R >> 6) * 62 + (R & 63)) : R; voffA[i] = (unsigned)(Ra * K + C) * 2u; voffB[i] = (unsigned)(Rb * K + C) * 2u; }
    const size_t kstep = (size_t)(BK * 2);
    const size_t hstep = (size_t)HALF * K * 2;
    const size_t tstep = 2 * hstep;
    const size_t hstepA = Epi::AREMAP ? (size_t)124 * K * 2 : hstep, tstepA = Epi::AREMAP ? (size_t)248 * K * 2 : tstep;
    const unsigned ldsw = (unsigned)wid * 1024u;
    const int aoff = lds_byte(wr * 64 + fr, fq * 8), boff = lds_byte(wc * 32 + fr, fq * 8);
#define PG8_SA(b, h) (((b) * 2 + (h)) * HTB)
#define PG8_SB(b, h) ((4 + (b) * 2 + (h)) * HTB)
#define PG8_STAGE(bufoff, gbase, voff) do { _Pragma("unroll") for (int _i = 0; _i < 2; ++_i) \
        __builtin_amdgcn_global_load_lds((const unsigned*)((const char*)(gbase) + (voff)[_i]), (PG8_LAS unsigned*)(lds + (bufoff) + ldsw + _i * 8192), 16, 0, 0); } while (0)
#define PG8_LDA(dst, b, h) do { _Pragma("unroll") for (int m = 0; m < 4; ++m) _Pragma("unroll") for (int k = 0; k < 2; ++k) dst[m][k] = *(const PG8_LAS bf16x8*)(lds + PG8_SA(b, h) + aoff + m * 2048 + k * 1024); } while (0)
#define PG8_LDB(dst, b, h) do { _Pragma("unroll") for (int n = 0; n < 2; ++n) _Pragma("unroll") for (int k = 0; k < 2; ++k) dst[n][k] = *(const PG8_LAS bf16x8*)(lds + PG8_SB(b, h) + boff + n * 2048 + k * 1024); } while (0)
#define PG8_MMA(ai, bj, At, Bt) do { __builtin_amdgcn_s_setprio(1); _Pragma("unroll") for (int m = 0; m < 4; ++m) _Pragma("unroll") for (int n = 0; n < 2; ++n) _Pragma("unroll") for (int k = 0; k < 2; ++k) \
        acc[ai][bj][m][n] = __builtin_amdgcn_mfma_f32_16x16x32_bf16(Bt[n][k], At[m][k], acc[ai][bj][m][n], 0, 0, 0); __builtin_amdgcn_s_setprio(0); } while (0)
#define PG8_WAIT_V(n) asm volatile("s_waitcnt vmcnt(" #n ")" ::: "memory")
#define PG8_WAIT_L(n) asm volatile("s_waitcnt lgkmcnt(" #n ")" ::: "memory")
#define PG8_BAR __builtin_amdgcn_s_barrier()
#define PG8_SCHED __builtin_amdgcn_sched_barrier(0)
    Unit cur, nxt; int ui = 0;
    if (!S.next(0, cur)) return;
    f32x4 acc[2][2][4][2];
#pragma unroll
    for (int a = 0; a < 2; ++a)
#pragma unroll
        for (int b = 0; b < 2; ++b)
#pragma unroll
            for (int m = 0; m < 4; ++m)
#pragma unroll
                for (int n = 0; n < 2; ++n) acc[a][b][m][n] = (f32x4){0.f, 0.f, 0.f, 0.f};
    bf16x8 At[4][2], B0[2][2], B1[2][2];
    const char* cA = (const char*)g.A + (size_t)cur.pm * tstepA; const char* cB = (const char*)g.Bt + (size_t)cur.pn * tstep;
    S.a_ready(cur);
    if constexpr (SP2) {
        PG8_STAGE(PG8_SB(0, 0), cB, voffB); PG8_STAGE(PG8_SB(0, 1), cB + hstep, voffB); PG8_STAGE(PG8_SA(0, 0), cA, voffA); PG8_STAGE(PG8_SA(0, 1), cA + hstepA, voffA);
        if (wr == 1) PG8_BAR;
        PG8_WAIT_V(2); PG8_BAR;
        PG8_STAGE(PG8_SB(1, 0), cB + kstep, voffB); PG8_STAGE(PG8_SA(1, 0), cA + kstep, voffA); PG8_STAGE(PG8_SB(1, 1), cB + hstep + kstep, voffB);
        PG8_WAIT_V(6); PG8_BAR;
    } else {
        PG8_STAGE(PG8_SB(0, 0), cB, voffB); PG8_STAGE(PG8_SA(0, 0), cA, voffA); PG8_STAGE(PG8_SB(0, 1), cB + hstep, voffB); PG8_STAGE(PG8_SA(0, 1), cA + hstepA, voffA);
        if (wr == 1) PG8_BAR;
        PG8_WAIT_V(4); PG8_BAR;
        PG8_STAGE(PG8_SB(1, 0), cB + kstep, voffB); PG8_STAGE(PG8_SA(1, 0), cA + kstep, voffA); PG8_STAGE(PG8_SB(1, 1), cB + hstep + kstep, voffB);
        PG8_WAIT_V(6); PG8_BAR;
    }
    for (;;) {
        const bool has_next = S.next(ui + 1, nxt);
        const char* nA = has_next ? (const char*)g.A + (size_t)nxt.pm * tstepA : cA; const char* nB = has_next ? (const char*)g.Bt + (size_t)nxt.pn * tstep : cB;
        for (int t = 0; t < nt; t += 2) {
            const bool last = (t == nt - 2);
            const char* a1 = cA + (size_t)(t + 1) * kstep;
            const char* a2 = last ? nA : cA + (size_t)(t + 2) * kstep; const char* b2 = last ? nB : cB + (size_t)(t + 2) * kstep;
            const char* a3 = a2 + kstep; const char* b3 = b2 + kstep;
            if (last && has_next) S.a_ready(nxt);
            if constexpr (SP2) {
            PG8_LDB(B0, 0, 0); PG8_LDB(B1, 0, 1); PG8_SCHED; PG8_LDA(At, 0, 0); PG8_STAGE(PG8_SA(1, 1), a1 + hstepA, voffA);
            PG8_WAIT_V(8); PG8_WAIT_L(0); PG8_BAR; PG8_MMA(0, 0, At, B0); PG8_MMA(0, 1, At, B1); PG8_BAR; PG8_SCHED;
            PG8_LDA(At, 0, 1); PG8_STAGE(PG8_SB(0, 0), b2, voffB); PG8_STAGE(PG8_SB(0, 1), b2 + hstep, voffB); PG8_STAGE(PG8_SA(0, 0), a2, voffA);
            PG8_WAIT_V(8); PG8_WAIT_L(0); PG8_BAR; PG8_MMA(1, 0, At, B0); PG8_MMA(1, 1, At, B1); PG8_BAR; PG8_SCHED;
            PG8_LDB(B0, 1, 0); PG8_LDB(B1, 1, 1); PG8_SCHED; PG8_LDA(At, 1, 0); PG8_STAGE(PG8_SA(0, 1), a2 + hstepA, voffA);
            PG8_WAIT_V(8); PG8_WAIT_L(0); PG8_BAR; PG8_MMA(0, 0, At, B0); PG8_MMA(0, 1, At, B1); PG8_BAR; PG8_SCHED;
            PG8_LDA(At, 1, 1); PG8_STAGE(PG8_SB(1, 0), b3, voffB); PG8_STAGE(PG8_SB(1, 1), b3 + hstep, voffB); PG8_STAGE(PG8_SA(1, 0), a3, voffA);
            PG8_WAIT_V(8); PG8_WAIT_L(0); PG8_BAR; PG8_MMA(1, 0, At, B0); PG8_MMA(1, 1, At, B1); PG8_BAR; PG8_SCHED;
            } else {
            PG8_LDB(B0, 0, 0); PG8_SCHED; PG8_LDA(At, 0, 0); PG8_STAGE(PG8_SA(1, 1), a1 + hstepA, voffA);
            PG8_WAIT_L(8); PG8_BAR; PG8_WAIT_L(0); PG8_MMA(0, 0, At, B0); PG8_BAR; PG8_SCHED;
            PG8_LDB(B1, 0, 1); PG8_STAGE(PG8_SB(0, 0), b2, voffB);
            PG8_BAR; PG8_WAIT_L(0); PG8_MMA(0, 1, At, B1); PG8_BAR;
            PG8_LDA(At, 0, 1); PG8_STAGE(PG8_SA(0, 0), a2, voffA);
            PG8_BAR; PG8_WAIT_L(0); PG8_MMA(1, 0, At, B0); PG8_BAR; PG8_SCHED;
            PG8_STAGE(PG8_SB(0, 1), b2 + hstep, voffB);
            PG8_WAIT_V(6); PG8_BAR; PG8_MMA(1, 1, At, B1); PG8_BAR;
            PG8_LDB(B0, 1, 0); PG8_SCHED; PG8_LDA(At, 1, 0); PG8_STAGE(PG8_SA(0, 1), a2 + hstepA, voffA);
            PG8_WAIT_L(8); PG8_BAR; PG8_WAIT_L(0); PG8_MMA(0, 0, At, B0); PG8_BAR; PG8_SCHED;
            PG8_LDB(B1, 1, 1); PG8_STAGE(PG8_SB(1, 0), b3, voffB);
            PG8_BAR; PG8_WAIT_L(0); PG8_MMA(0, 1, At, B1); PG8_BAR;
            PG8_LDA(At, 1, 1); PG8_STAGE(PG8_SA(1, 0), a3, voffA);
            PG8_BAR; PG8_WAIT_L(0); PG8_MMA(1, 0, At, B0); PG8_BAR; PG8_SCHED;
            PG8_STAGE(PG8_SB(1, 1), b3 + hstep, voffB);
            PG8_WAIT_V(6); PG8_BAR; PG8_MMA(1, 1, At, B1); PG8_BAR;
            }
        }
        if constexpr (ALIGN_EPI) { if (wr == 0) PG8_BAR; }
        if constexpr (!Epi::AFTER_DRAIN) { E(acc, cur, wr, wc, fr, fq); S.done(cur); }
        if (!has_next) break;
#pragma unroll
        for (int a = 0; a < 2; ++a)
#pragma unroll
            for (int b = 0; b < 2; ++b)
#pragma unroll
                for (int m = 0; m < 4; ++m)
#pragma unroll
                    for (int n = 0; n < 2; ++n) acc[a][b][m][n] = (f32x4){0.f, 0.f, 0.f, 0.f};
        cur = nxt; cA = nA; cB = nB; ++ui;
        if constexpr (ALIGN_EPI) { if (wr == 1) PG8_BAR; }
    }
    PG8_WAIT_V(0);
    if constexpr (!ALIGN_EPI) { if (wr == 0) PG8_BAR; }
    PG8_BAR;
    if constexpr (Epi::AFTER_DRAIN) { E.fused(acc, cur, wr, wc, fr, fq, lds, wid, lane); S.done(cur); }
#undef PG8_SA
#undef PG8_SB
#undef PG8_STAGE
#undef PG8_LDA
#undef PG8_LDB
#undef PG8_MMA
#undef PG8_WAIT_V
#undef PG8_WAIT_L
#undef PG8_BAR
#undef PG8_SCHED
}
}
#define LAS __attribute__((address_space(3)))
typedef LAS unsigned char* ldsp;
typedef unsigned short bf16_t;
typedef short bf16x8 __attribute__((ext_vector_type(8)));
typedef short s16x4 __attribute__((ext_vector_type(4)));
typedef float f32x4 __attribute__((ext_vector_type(4)));
typedef float f32x16 __attribute__((ext_vector_type(16)));
typedef unsigned u32x4 __attribute__((ext_vector_type(4)));
typedef unsigned u32x2 __attribute__((ext_vector_type(2)));
typedef float f32x2_t __attribute__((ext_vector_type(2))); typedef __bf16 bf16x2_t __attribute__((ext_vector_type(2)));
__device__ __forceinline__ unsigned cvt_pk_bf16(float lo, float hi) { f32x2_t v = {lo, hi}; bf16x2_t b = __builtin_convertvector(v, bf16x2_t); return __builtin_bit_cast(unsigned, b); }

constexpr int DM = 1024, NBATCH = 4, SEQ = 8192, CTXL = 256;
constexpr int NLAT = NBATCH * SEQ, NCTX = NBATCH * CTXL, MTOT = NLAT + NCTX;
constexpr int PW = 1792;
constexpr int PTR = 1024;
constexpr int DFF = 2816, NUP = 2 * DFF, NMOD = 6 * DM, INW = 2816;
constexpr int NCH = 66;
constexpr float LOG2E = 1.4426950408889634f;
constexpr float C2 = 0.125f * LOG2E;
constexpr float KRS = 0.17677669529663687f;
constexpr float EPS = 1e-6f;
constexpr int PC_QA = 0, PC_KA = 256, PC_QB = 384, PC_KB = 896, PC_QR = 1408, PC_KR = 1536, PC_GR = 1664;
constexpr int PR_VA = 0, PR_VB = 128, PR_VR = 640, PR_GR2 = 896;

constexpr size_t MiB = 1u << 20;
constexpr size_t WS_MOD = 0, WS_SCAL = 256 * 1024, CTL_ZERO = 1 * MiB;
constexpr size_t WS_WIN = 1 * MiB, WS_WOUT = 13 * MiB, WS_WUP = 17 * MiB, WS_WDN = 39 * MiB;
constexpr size_t WS_ROPE = 50 * MiB, WS_XC = 54 * MiB, WS_H = 58 * MiB;
constexpr size_t WS_P = 126 * MiB, WS_PT = 258 * MiB, WS_MIX = 324 * MiB, WS_STASH = 390 * MiB, WS_KV = 456 * MiB, WS_ST = 473 * MiB;
constexpr size_t WS_A = 126 * MiB, WS_END = 490 * MiB;
constexpr size_t WS_XBF = 390 * MiB;
constexpr int LDS_BYTES = 147456;
constexpr int LDS_ST_OFF = 131072 + 256;
constexpr size_t WS_BAR = 512 * 1024;
constexpr size_t WS_CWP = 768 * 1024;

struct Args { const float* in[19]; float* out; unsigned char* ws; };
typedef const __attribute__((address_space(4))) Args* KArgs;
enum { I_X = 0, I_C, I_CTX, I_CCTX, I_WMOD, I_BMOD, I_N1G, I_N2G, I_WIN, I_WOUT, I_SINK, I_DLAM, I_SUBG, I_RDL, I_WUP, I_CONVW, I_CONVB, I_WDN, I_FG };

__device__ __forceinline__ float bf2f(unsigned short b) { return __uint_as_float(((unsigned)b) << 16); }
__device__ __forceinline__ float bflo(unsigned w) { return __uint_as_float(w << 16); }
__device__ __forceinline__ float bfhi(unsigned w) { return __uint_as_float(w & 0xffff0000u); }
__device__ __forceinline__ float wave_sum(float v) {
#pragma unroll
    for (int o = 1; o < 64; o <<= 1) v += __shfl_xor(v, o);
    return v;
}
__device__ __forceinline__ float half_sum(float v) {
#pragma unroll
    for (int o = 1; o < 32; o <<= 1) v += __shfl_xor(v, o);
    return v;
}
__device__ __forceinline__ float silu_f(float x) { return x * __builtin_amdgcn_rcpf(1.f + __builtin_amdgcn_exp2f(-LOG2E * x)); }
__device__ __forceinline__ int crow(int r, int hi) { return (r & 3) + 8 * (r >> 2) + 4 * hi; }
__device__ __forceinline__ int mod_index(int row) { return row < NLAT ? (row >> 13) : 4; }

struct EpiStoreBf16 {
    static constexpr bool PERM = true, AFTER_DRAIN = false, AREMAP = false;
    bf16_t* O; int ldc;
    __device__ __forceinline__ void operator()(const f32x4 (&acc)[2][2][4][2], const pg8::Unit& u, int wr, int wc, int fr, int fq) const {
        const int row0 = u.pm * 256 + wr * 64 + fr, col0 = u.pn * 256 + wc * 32 + 8 * fq;
#pragma unroll
        for (int ai = 0; ai < 2; ++ai)
#pragma unroll
            for (int m = 0; m < 4; ++m) { bf16_t* rowp = O + (size_t)(row0 + ai * 128 + m * 16) * ldc + col0;
#pragma unroll
                for (int bj = 0; bj < 2; ++bj) { const f32x4 v0 = acc[ai][bj][m][0], v1 = acc[ai][bj][m][1];
                    u32x4 w; w.x = cvt_pk_bf16(v0[0], v0[1]); w.y = cvt_pk_bf16(v0[2], v0[3]); w.z = cvt_pk_bf16(v1[0], v1[1]); w.w = cvt_pk_bf16(v1[2], v1[3]);
                    *(u32x4*)(rowp + bj * 128) = w; } }
    }
};
struct EpiInTok {
    static constexpr bool PERM = true, AFTER_DRAIN = false, AREMAP = false;
    bf16_t* P; const float* c64; const float* s64; const float* c32; const float* s32;
    __device__ __forceinline__ void operator()(const f32x4 (&acc)[2][2][4][2], const pg8::Unit& u, int wr, int wc, int fr, int fq) const {
        const int row0 = u.pm * 256 + wr * 64 + fr;
        const bool lat = (u.pm * 256) < NLAT;
#pragma unroll
        for (int bj = 0; bj < 2; ++bj) {
            const int seg = 2 * u.pn + bj, cb = u.pn * 256 + bj * 128 + wc * 32 + 8 * fq;
            const int mode = (seg <= 10) ? 1 : ((seg <= 12) ? 2 : 0);
            const float sc = (seg <= 1 || (seg >= 3 && seg <= 6)) ? C2 : ((seg == 12) ? KRS : 1.f);
#pragma unroll
            for (int ai = 0; ai < 2; ++ai)
#pragma unroll
                for (int m = 0; m < 4; ++m) {
                    const int row = row0 + ai * 128 + m * 16;
                    f32x4 v0 = acc[ai][bj][m][0], v1 = acc[ai][bj][m][1];
                    if (mode != 0 && lat) {
                        const int t = row & (SEQ - 1);
                        f32x4 cs, sn;
                        if (mode == 1) { const int i0 = (cb & 63) >> 1; cs = *(const f32x4*)(c64 + t * 32 + i0); sn = *(const f32x4*)(s64 + t * 32 + i0); }
                        else { const int i0 = (cb & 31) >> 1; cs = *(const f32x4*)(c32 + t * 16 + i0); sn = *(const f32x4*)(s32 + t * 16 + i0); }
                        f32x4 a0, a1;
                        a0[0] = v0[0] * cs[0] - v0[1] * sn[0]; a0[1] = v0[0] * sn[0] + v0[1] * cs[0];
                        a0[2] = v0[2] * cs[1] - v0[3] * sn[1]; a0[3] = v0[2] * sn[1] + v0[3] * cs[1];
                        a1[0] = v1[0] * cs[2] - v1[1] * sn[2]; a1[1] = v1[0] * sn[2] + v1[1] * cs[2];
                        a1[2] = v1[2] * cs[3] - v1[3] * sn[3]; a1[3] = v1[2] * sn[3] + v1[3] * cs[3];
                        v0 = a0; v1 = a1;
                    }
                    v0 = v0 * sc; v1 = v1 * sc;
                    u32x4 w; w.x = cvt_pk_bf16(v0[0], v0[1]); w.y = cvt_pk_bf16(v0[2], v0[3]); w.z = cvt_pk_bf16(v1[0], v1[1]); w.w = cvt_pk_bf16(v1[2], v1[3]);
                    *(u32x4*)(P + (size_t)row * PW + cb) = w;
                }
        }
    }
};
struct EpiResid {
    static constexpr bool PERM = true, AFTER_DRAIN = false, AREMAP = false;
    const float* xin_lat; const float* xin_ctx; bf16_t* Xb; const float* gate;
    __device__ __forceinline__ void operator()(const f32x4 (&acc)[2][2][4][2], const pg8::Unit& u, int wr, int wc, int fr, int fq) const {
        const int rowt = u.pm * 256; const int mi = mod_index(rowt);
        const float* xi = xin_lat ? (rowt < NLAT ? xin_lat + (size_t)rowt * DM : xin_ctx + (size_t)(rowt - NLAT) * DM) : nullptr;
        bf16_t* xo = Xb + (size_t)rowt * DM;
        const int col0 = u.pn * 256 + wc * 32 + 8 * fq;
#pragma unroll
        for (int bj = 0; bj < 2; ++bj) {
            const f32x4 g0 = *(const f32x4*)(gate + (size_t)mi * NMOD + col0 + bj * 128), g1 = *(const f32x4*)(gate + (size_t)mi * NMOD + col0 + bj * 128 + 4);
#pragma unroll
            for (int ai = 0; ai < 2; ++ai)
#pragma unroll
                for (int m = 0; m < 4; ++m) {
                    const size_t off = (size_t)(ai * 128 + wr * 64 + m * 16 + fr) * DM + col0 + bj * 128;
                    f32x4 x0, x1;
                    if (xi) { x0 = *(const f32x4*)(xi + off); x1 = *(const f32x4*)(xi + off + 4); }
                    else { const u32x4 w = *(const u32x4*)(xo + off); x0 = (f32x4){bflo(w.x), bfhi(w.x), bflo(w.y), bfhi(w.y)}; x1 = (f32x4){bflo(w.z), bfhi(w.z), bflo(w.w), bfhi(w.w)}; }
                    const f32x4 y0 = x0 + g0 * acc[ai][bj][m][0], y1 = x1 + g1 * acc[ai][bj][m][1];
                    u32x4 o; o.x = cvt_pk_bf16(y0[0], y0[1]); o.y = cvt_pk_bf16(y0[2], y0[3]); o.z = cvt_pk_bf16(y1[0], y1[1]); o.w = cvt_pk_bf16(y1[2], y1[3]);
                    *(u32x4*)(xo + off) = o;
                }
        }
    }
};

__device__ __forceinline__ float dpp_ror1(float v) { return __int_as_float(__builtin_amdgcn_update_dpp(0, __float_as_int(v), 0x121, 0xf, 0xf, false)); }
__device__ __forceinline__ float dpp_ror15(float v) { return __int_as_float(__builtin_amdgcn_update_dpp(0, __float_as_int(v), 0x12F, 0xf, 0xf, false)); }
__device__ __forceinline__ bool seq_first(int row) { return row < NLAT ? ((row & (SEQ - 1)) == 0) : (((row - NLAT) & (CTXL - 1)) == 0); }
struct EpiUpConv {
    static constexpr bool PERM = true, AFTER_DRAIN = false, AREMAP = true;
    bf16_t* A; const float* cw; int M;
    __device__ __forceinline__ void operator()(const f32x4 (&acc)[2][2][4][2], const pg8::Unit& u, int wr, int wc, int fr_, int fq_) const {
        int fr = fr_, fq = fq_; asm volatile("" : "+v"(fr), "+v"(fq));
        const int lane = fq * 16 + fr;
        const int srcp = (lane & 48) | ((fr + 15) & 15), srcn = (lane & 48) | ((fr + 1) & 15);
        const int chb = u.pn * 128 + wc * 32 + 8 * fq;
#pragma unroll
        for (int n = 0; n < 2; ++n) {
            const int ch = chb + 4 * n;
            f32x4 wvs[4], wgs[4];
#pragma unroll
            for (int e = 0; e < 4; ++e) { wvs[e] = *(const f32x4*)(cw + (size_t)(ch + e) * 8); wgs[e] = *(const f32x4*)(cw + (size_t)(ch + e) * 8 + 4); }
#pragma unroll
            for (int ai = 0; ai < 2; ++ai) {
                const int rowbase = u.pm * 248 + 62 * (2 * ai + wr) - 1;
                float ov[4][4]; int sp_ = srcp, sn_ = srcn;
#pragma unroll
                for (int e = 0; e < 4; ++e) {
                    const f32x4 wva = wvs[e], wga = wgs[e];
                    const float wv0 = wva[0], wv1 = wva[1], wv2 = wva[2], bv = wva[3], wg0 = wga[0], wg1 = wga[1], wg2 = wga[2], bg = wga[3];
#pragma unroll
                    for (int m = 0; m < 4; ++m) {
                        const int t = rowbase + 16 * m + fr;
                        const float cv = acc[ai][0][m][n][e], cg = acc[ai][1][m][n][e];
                        const float cvm = m > 0 ? acc[ai][0][m > 0 ? m - 1 : 0][n][e] : 0.f, cgm = m > 0 ? acc[ai][1][m > 0 ? m - 1 : 0][n][e] : 0.f;
                        const float cvp = m < 3 ? acc[ai][0][m < 3 ? m + 1 : 3][n][e] : 0.f, cgp = m < 3 ? acc[ai][1][m < 3 ? m + 1 : 3][n][e] : 0.f;
                        float pv = dpp_ror1(fr == 15 ? cvm : cv), pg = dpp_ror1(fr == 15 ? cgm : cg);
                        float nv = dpp_ror15(fr == 0 ? cvp : cv), ng = dpp_ror15(fr == 0 ? cgp : cg);
                        if (seq_first(t)) { pv = 0.f; pg = 0.f; }
                        if (seq_first(t + 1)) { nv = 0.f; ng = 0.f; }
                        const float val = wv0 * pv + wv1 * cv + wv2 * nv + bv;
                        const float gat = wg0 * pg + wg1 * cg + wg2 * ng + bg;
                        ov[m][e] = silu_f(gat) * val;
                        __builtin_amdgcn_sched_barrier(0);
                    }
                    if (e == 3) asm volatile("" : "+v"(ov[0][0]), "+v"(ov[1][0]), "+v"(ov[2][0]), "+v"(ov[3][0]), "+v"(ov[0][1]), "+v"(ov[1][1]), "+v"(ov[2][1]), "+v"(ov[3][1]), "+v"(ov[0][2]), "+v"(ov[1][2]), "+v"(ov[2][2]), "+v"(ov[3][2]), "+v"(ov[0][3]), "+v"(ov[1][3]), "+v"(ov[2][3]), "+v"(ov[3][3]), "+v"(sp_), "+v"(sn_));
                }
#pragma unroll
                for (int m = 0; m < 4; ++m) {
                    const int rho = 16 * m + fr, t = rowbase + rho;
                    if (rho >= 1 && rho <= 62 && t < M) { u32x2 w; w.x = cvt_pk_bf16(ov[m][0], ov[m][1]); w.y = cvt_pk_bf16(ov[m][2], ov[m][3]); *(u32x2*)(A + (size_t)t * DFF + ch) = w; }
                }
            }
        }
    }
};
#define XB_TMO      128
#define XB_XCNT(j)  (256  + 64 * (j))
#define XB_XSUB(j)  (1280 + 64 * (j))
#define XB_XGEN(j)  (2304 + 64 * (j))
#define XB_TOP      3328
#define XB_TOPGEN   3392
#define XCD_BAR_WORDS 3456
#define XB_SPIN_CAP (1u << 18)

__device__ __forceinline__ unsigned xb_ld(unsigned* p)              { return __hip_atomic_load(p, __ATOMIC_RELAXED, __HIP_MEMORY_SCOPE_AGENT); }
__device__ __forceinline__ unsigned xb_add(unsigned* p, unsigned v) { return __hip_atomic_fetch_add(p, v, __ATOMIC_RELAXED, __HIP_MEMORY_SCOPE_AGENT); }
__device__ __forceinline__ unsigned xb_xcc_id() { return (unsigned)__builtin_amdgcn_s_getreg((3 << 11) | 20) & 0xFu; }
#define XB_SPIN(cond, bar) do { unsigned _sp = 0; while (cond) { __builtin_amdgcn_s_sleep(1); \
    if ((++_sp & 255u) == 0u) { if (xb_ld(&(bar)[XB_TMO])) break; if (_sp > XB_SPIN_CAP) { atomicAdd(&(bar)[XB_TMO], 1u); break; } } } } while (0)

struct XcdBarrier {
    unsigned* bar; unsigned x;
    volatile LAS unsigned* st;
};

__device__ __forceinline__ XcdBarrier xcd_barrier_post(unsigned* bar, volatile LAS unsigned* st) {
    XcdBarrier b; b.bar = bar; b.x = xb_xcc_id(); b.st = st;
    if (threadIdx.x == 0) (void)xb_add(&bar[XB_XCNT(b.x)], 1u);
    return b;
}
__device__ __forceinline__ void xcd_barrier_complete(unsigned* bar, unsigned x, unsigned& nloc, unsigned& nx) {
    const unsigned G = gridDim.x * gridDim.y * gridDim.z;
    unsigned sum, cnt, mine, sp = 0u;
    for (;;) {
        sum = 0u; cnt = 0u; mine = 0u;
#pragma unroll
        for (unsigned j = 0; j < 16; ++j) { const unsigned c = xb_ld(&bar[XB_XCNT(j)]); sum += c; cnt += (c > 0u) ? 1u : 0u; mine = (j == x) ? c : mine; }
        if (sum == G) break;
        __builtin_amdgcn_s_sleep(1);
        if ((++sp & 255u) == 0u) { if (xb_ld(&bar[XB_TMO])) break; if (sp > XB_SPIN_CAP) { atomicAdd(&bar[XB_TMO], 1u); break; } }
    }
    nloc = mine > 0u ? mine : 1u; nx = cnt > 0u ? cnt : 1u;
}

__device__ __forceinline__ void xcd_barrier(const XcdBarrier& b) {
    asm volatile("s_waitcnt vmcnt(0)" ::: "memory");
    __syncthreads();
    if (threadIdx.x == 0) {
        unsigned* bar = b.bar;
        __builtin_amdgcn_s_waitcnt(0);
        unsigned nloc = b.st[0], nx = b.st[1];
        if (nloc == 0u) { xcd_barrier_complete(bar, b.x, nloc, nx); b.st[0] = nloc; b.st[1] = nx; }
        const unsigned old = xb_add(&bar[XB_XSUB(b.x)], 1u);
        const unsigned gen = old / nloc;
        if (old + 1u == (gen + 1u) * nloc) {
            __builtin_amdgcn_fence(__ATOMIC_RELEASE, "agent");
            asm volatile("s_waitcnt vmcnt(0)" ::: "memory");
            const unsigned og = xb_add(&bar[XB_TOP], 1u);
            const unsigned tg = og / nx;
            if (og + 1u == (tg + 1u) * nx) xb_add(&bar[XB_TOPGEN], 1u);
            else XB_SPIN(xb_ld(&bar[XB_TOPGEN]) == tg, bar);
            __builtin_amdgcn_fence(__ATOMIC_ACQUIRE, "agent");
            xb_add(&bar[XB_XGEN(b.x)], 1u);
            asm volatile("s_waitcnt vmcnt(0)" ::: "memory");
        } else {
            XB_SPIN(xb_ld(&bar[XB_XGEN(b.x)]) == gen, bar);
            __builtin_amdgcn_fence(__ATOMIC_ACQUIRE, "agent");
            asm volatile("s_waitcnt vmcnt(0)" ::: "memory");
        }
    }
    __syncthreads();
}
__device__ __forceinline__ int src_in(int r) {
    if (r < PW) {
        int d, s, hd;
        if (r < 256) { d = 0; s = 0; hd = 64; }
        else if (r < 384) { d = 256; s = 256; hd = 64; }
        else if (r < 896) { d = 384; s = 512; hd = 64; }
        else if (r < 1408) { d = 896; s = 1024; hd = 64; }
        else if (r < 1536) { d = 1408; s = 2048; hd = 32; }
        else if (r < 1664) { d = 1536; s = 2176; hd = 32; }
        else { d = 1664; s = 2560; hd = 0; }
        int jl = r - d;
        if (hd) { const int head = jl / hd, p = jl % hd; jl = head * hd + (p & 1) * (hd / 2) + (p >> 1); }
        return s + jl;
    }
    const int q = r - PW;
    if (q < 128) return 384 + q;
    if (q < 640) return 1536 + (q - 128);
    if (q < 896) return 2304 + (q - 640);
    return 2560 + 128 + (q - 896);
}
__device__ __forceinline__ void transpose_item(const float* W, int K, int N, bf16_t* WT, int inmap, volatile LAS float* scr, int item, int nblk, int lane) {
    const int kb = item / nblk, nb = item % nblk, k0 = 64 * kb, n0 = 32 * nb;
    const int nn = n0 + (lane & 31); const int sc = inmap == 1 ? src_in(nn) : (inmap == 2 ? (((nn & 255) < 128) ? 128 * (nn >> 8) + (nn & 255) : DFF + 128 * (nn >> 8) + (nn & 255) - 128) : nn);
#pragma unroll 8
    for (int i = 0; i < 32; ++i) { const int kk = 2 * i + (lane >> 5); scr[kk * 33 + (lane & 31)] = sc >= 0 ? W[(size_t)(k0 + kk) * N + sc] : 0.f; }
    const int c = lane & 7;
#pragma unroll
    for (int j = 0; j < 4; ++j) { const int n = (lane >> 3) + 8 * j; volatile LAS float* s = scr + (8 * c) * 33 + n;
        u32x4 o; o.x = cvt_pk_bf16(s[0 * 33], s[1 * 33]); o.y = cvt_pk_bf16(s[2 * 33], s[3 * 33]); o.z = cvt_pk_bf16(s[4 * 33], s[5 * 33]); o.w = cvt_pk_bf16(s[6 * 33], s[7 * 33]);
        *(u32x4*)(WT + (size_t)(n0 + n) * K + k0 + 8 * c) = o; }
}
__device__ __forceinline__ float inv_freq(int j, int nf) {
    const int jj = (nf == 16) ? j : 2 * j;
    const int q = jj >> 2, r = jj & 3;
    const float b = r == 0 ? 1.0f : (r == 1 ? 0.5623413251903491f : (r == 2 ? 0.31622776601683794f : 0.17782794100389228f));
    const float p = q == 0 ? 1.0f : (q == 1 ? 0.1f : (q == 2 ? 0.01f : 0.001f));
    return b * p;
}
__device__ __forceinline__ void prep_phase(KArgs a, ldsp lds, int G) {
    const int tid = ltid(), lane = tid & 63, wid = tid >> 6, bid = lbid();
    unsigned char* ws = a->ws;
    float* modv = (float*)(ws + WS_MOD);
    {
        volatile LAS float* sl = (volatile LAS float*)(lds);
        volatile LAS float* red = (volatile LAS float*)(lds + 5 * 1024 * 4);
        for (int i = tid; i < 5 * DM; i += 512) sl[i] = silu_f(i < 4 * DM ? a->in[I_C][i] : a->in[I_CCTX][i - 4 * DM]);
        __syncthreads();
        const int kc = tid >> 5, j = tid & 31;
        for (int item = bid; item < 2 * 192; item += G) {
            const int l = item / 192, nb = item % 192, n = nb * 32 + j;
            float acc[5] = {0.f, 0.f, 0.f, 0.f, 0.f};
            const float* wm = a->in[I_WMOD] + ((size_t)l * DM + kc * 64) * NMOD + n;
#pragma unroll 8
            for (int kk = 0; kk < 64; ++kk) {
                const float w = wm[(size_t)kk * NMOD];
#pragma unroll
                for (int mi = 0; mi < 5; ++mi) acc[mi] += sl[mi * DM + kc * 64 + kk] * w;
            }
#pragma unroll
            for (int mi = 0; mi < 5; ++mi) red[(kc * 5 + mi) * 32 + j] = acc[mi];
            __syncthreads();
            if (tid < 160) {
                const int mi = tid >> 5;
                float s = a->in[I_BMOD][l * NMOD + n];
#pragma unroll
                for (int q = 0; q < 16; ++q) s += red[(q * 5 + mi) * 32 + j];
                modv[(size_t)(l * 5 + mi) * NMOD + n] = s;
            }
            __syncthreads();
        }
    }
    if (bid == 0) {
        float* scal = (float*)(ws + WS_SCAL);
        if (tid < 2) {
            const float* dl = a->in[I_DLAM] + tid * 256;
            float s1 = 0.f, s2 = 0.f;
            for (int i = 0; i < 64; ++i) { s1 += dl[i] * dl[64 + i]; s2 += dl[128 + i] * dl[192 + i]; }
            const float lam_init = 0.8f - 0.6f * expf(-0.3f * (float)tid);
            scal[tid] = expf(s1) - expf(s2) + lam_init;
            scal[2 + tid] = lam_init;
        } else if (tid >= 64 && tid < 80) {
            const int i = tid - 64;
            const float x = a->in[I_RDL][i];
            scal[8 + i] = -log1pf(expf(-x)) * LOG2E;
        }
    }
    {
        float* cwp = (float*)(ws + WS_CWP);
        for (int i = bid * 512 + tid; i < 2 * DFF; i += G * 512) {
            const int l = i / DFF, ch = i % DFF;
            const float* w = a->in[I_CONVW] + (size_t)l * 3 * NUP; const float* b = a->in[I_CONVB] + (size_t)l * NUP;
            f32x4 va = {w[ch], w[NUP + ch], w[2 * NUP + ch], b[ch]}, ga = {w[DFF + ch], w[NUP + DFF + ch], w[2 * NUP + DFF + ch], b[DFF + ch]};
            *(f32x4*)(cwp + (size_t)i * 8) = va; *(f32x4*)(cwp + (size_t)i * 8 + 4) = ga;
        }
    }
    {
        float* c64 = (float*)(ws + WS_ROPE); float* s64 = c64 + SEQ * 32; float* c32 = s64 + SEQ * 32; float* s32 = c32 + SEQ * 16;
        for (int e = bid * 512 + tid; e < SEQ * 48; e += G * 512) {
            const int t = e / 48, i = e % 48;
            float ang;
            if (i < 32) { const float pos = (float)((i < 16) ? (t >> 6) : (t & 63)); ang = pos * inv_freq(i & 15, 16); }
            else { const int ii = i - 32; const float pos = (float)((ii < 8) ? (t >> 6) : (t & 63)); ang = pos * inv_freq(ii & 7, 8); }
            double rv = (double)ang * 0.15915494309189535; rv -= rint(rv);
            const float rr = (float)rv;
            const float sn = __builtin_amdgcn_sinf(rr), cs = __builtin_amdgcn_cosf(rr);
            if (i < 32) { c64[t * 32 + i] = cs; s64[t * 32 + i] = sn; } else { c32[t * 16 + i - 32] = cs; s32[t * 16 + i - 32] = sn; }
        }
    }
    {
        volatile LAS float* scr = (volatile LAS float*)(lds + wid * 16384);
        const int gw = bid * 8 + wid, NGW = G * 8;
        constexpr int I_IN = 16 * 88, I_OUT = 16 * 32, I_UP = 16 * 176, I_DN = 44 * 32, I_L = I_IN + I_OUT + I_UP + I_DN;
        for (int it = gw; it < 2 * I_L; it += NGW) {
            const int l = it / I_L; int r = it % I_L;
            if (r < I_IN) { transpose_item(a->in[I_WIN] + (size_t)l * DM * INW, DM, INW, (bf16_t*)(ws + WS_WIN) + (size_t)l * 3072 * DM, 1, scr, r, 88, lane); continue; } r -= I_IN;
            if (r < I_OUT) { transpose_item(a->in[I_WOUT] + (size_t)l * DM * DM, DM, DM, (bf16_t*)(ws + WS_WOUT) + (size_t)l * DM * DM, 0, scr, r, 32, lane); continue; } r -= I_OUT;
            if (r < I_UP) { transpose_item(a->in[I_WUP] + (size_t)l * DM * NUP, DM, NUP, (bf16_t*)(ws + WS_WUP) + (size_t)l * NUP * DM, 2, scr, r, 176, lane); continue; } r -= I_UP;
            transpose_item(a->in[I_WDN] + (size_t)l * DFF * DM, DFF, DM, (bf16_t*)(ws + WS_WDN) + (size_t)l * DM * DFF, 0, scr, r, 32, lane);
        }
    }
}
constexpr int NRW = 4;
__device__ __forceinline__ void norm_phase(const float* xl, const float* xc, const bf16_t* Xb, const float* g, const float* modl, int shi, int sci, bf16_t* H, int M, int G) {
    const int tid = ltid(), lane = tid & 63, wid = tid >> 6;
    const int gw = lbid() * 8 + wid, NGW = G * 8;
    for (int row0 = gw; row0 < M; row0 += NRW * NGW) {
        f32x4 v[NRW][4]; float ss[NRW];
#pragma unroll
        for (int q = 0; q < NRW; ++q) {
            const int row = row0 + q * NGW;
            if (row < M) {
                if (xl) {
                    const float* xr = row < NLAT ? xl + (size_t)row * DM : xc + (size_t)(row - NLAT) * DM;
#pragma unroll
                    for (int j = 0; j < 2; ++j) { v[q][2 * j] = *(const f32x4*)(xr + 512 * j + 8 * lane); v[q][2 * j + 1] = *(const f32x4*)(xr + 512 * j + 8 * lane + 4); }
                } else {
#pragma unroll
                    for (int j = 0; j < 2; ++j) { const u32x4 w = *(const u32x4*)(Xb + (size_t)row * DM + 512 * j + 8 * lane);
                        v[q][2 * j] = (f32x4){bflo(w.x), bfhi(w.x), bflo(w.y), bfhi(w.y)}; v[q][2 * j + 1] = (f32x4){bflo(w.z), bfhi(w.z), bflo(w.w), bfhi(w.w)}; }
                }
            } else {
#pragma unroll
                for (int j = 0; j < 4; ++j) v[q][j] = (f32x4){0.f, 0.f, 0.f, 0.f};
            }
        }
#pragma unroll
        for (int q = 0; q < NRW; ++q) { float s = 0.f;
#pragma unroll
            for (int j = 0; j < 4; ++j) s += (v[q][j][0] * v[q][j][0] + v[q][j][1] * v[q][j][1]) + (v[q][j][2] * v[q][j][2] + v[q][j][3] * v[q][j][3]);
            ss[q] = s; }
#pragma unroll
        for (int o = 1; o < 64; o <<= 1) {
#pragma unroll
            for (int q = 0; q < NRW; ++q) ss[q] += __shfl_xor(ss[q], o);
        }
#pragma unroll
        for (int q = 0; q < NRW; ++q) {
            const int row = row0 + q * NGW;
            if (row < M) {
                const int mi = mod_index(row);
                const float rstd = rsqrtf(ss[q] * (1.f / DM) + EPS);
#pragma unroll
                for (int j = 0; j < 2; ++j) {
                    u32x4 o;
#pragma unroll
                    for (int h = 0; h < 2; ++h) {
                        const int col = 512 * j + 8 * lane + 4 * h;
                        const f32x4 gg = *(const f32x4*)(g + col);
                        const f32x4 sc = *(const f32x4*)(modl + (size_t)mi * NMOD + sci * DM + col);
                        const f32x4 sh = *(const f32x4*)(modl + (size_t)mi * NMOD + shi * DM + col);
                        const f32x4 y = (v[q][2 * j + h] * rstd) * gg * (sc + 1.0f) + sh;
                        if (h == 0) { o.x = cvt_pk_bf16(y[0], y[1]); o.y = cvt_pk_bf16(y[2], y[3]); } else { o.z = cvt_pk_bf16(y[0], y[1]); o.w = cvt_pk_bf16(y[2], y[3]); }
                    }
                    *(u32x4*)(H + (size_t)row * DM + 512 * j + 8 * lane) = o;
                }
            }
        }
    }
}
__device__ __forceinline__ void final_norm_phase(const bf16_t* Xb, float* out, const float* g, int G) {
    const int tid = ltid(), lane = tid & 63, wid = tid >> 6;
    const int gw = lbid() * 8 + wid, NGW = G * 8;
    f32x4 gq[4];
#pragma unroll
    for (int j = 0; j < 4; ++j) gq[j] = *(const f32x4*)(g + 512 * (j >> 1) + 8 * lane + 4 * (j & 1));
    for (int row0 = gw; row0 < NLAT; row0 += NRW * NGW) {
        f32x4 v[NRW][4]; float ss[NRW];
#pragma unroll
        for (int q = 0; q < NRW; ++q) {
            const int row = row0 + q * NGW;
#pragma unroll
            for (int j = 0; j < 2; ++j) {
                u32x4 w = {0u, 0u, 0u, 0u};
                if (row < NLAT) w = *(const u32x4*)(Xb + (size_t)row * DM + 512 * j + 8 * lane);
                v[q][2 * j] = (f32x4){bflo(w.x), bfhi(w.x), bflo(w.y), bfhi(w.y)}; v[q][2 * j + 1] = (f32x4){bflo(w.z), bfhi(w.z), bflo(w.w), bfhi(w.w)};
            }
        }
#pragma unroll
        for (int q = 0; q < NRW; ++q) { float s = 0.f;
#pragma unroll
            for (int j = 0; j < 4; ++j) s += (v[q][j][0] * v[q][j][0] + v[q][j][1] * v[q][j][1]) + (v[q][j][2] * v[q][j][2] + v[q][j][3] * v[q][j][3]);
            ss[q] = s; }
#pragma unroll
        for (int o = 1; o < 64; o <<= 1) {
#pragma unroll
            for (int q = 0; q < NRW; ++q) ss[q] += __shfl_xor(ss[q], o);
        }
#pragma unroll
        for (int q = 0; q < NRW; ++q) {
            const int row = row0 + q * NGW;
            if (row < NLAT) {
                const float rstd = rsqrtf(ss[q] * (1.f / DM) + EPS);
#pragma unroll
                for (int j = 0; j < 4; ++j) { const int col = 512 * (j >> 1) + 8 * lane + 4 * (j & 1); __builtin_nontemporal_store((v[q][j] * rstd) * gq[j], (f32x4*)(out + (size_t)row * DM + col)); }
            }
        }
    }
}
__device__ __forceinline__ float max3f(float a, float b, float c) { float r; asm("v_max3_f32 %0, %1, %2, %3" : "=v"(r) : "v"(a), "v"(b), "v"(c)); return r; }
#define MFMA32(a, b, c) __builtin_amdgcn_mfma_f32_32x32x16_bf16((a), (b), (c), 0, 0, 0)
struct AttnSeg { const bf16_t* Kc; const bf16_t* Kl; const bf16_t* Vc; const bf16_t* Vl; int nctx, t0, t1; };
constexpr int ATT_KB = 64 * 144;
constexpr int ATT_VS = 144;
constexpr int ATT_VB = 128 * ATT_VS;
constexpr int ATT_VOFF = 2 * ATT_KB;
constexpr int ATT_WSF = ATT_VOFF + 3 * ATT_VB;

template <int DV, bool WIN>
__device__ __forceinline__ void attn_pass(ldsp lds, const AttnSeg& S, const bf16x8 (&qr)[4], int qpos, f32x16 (&o)[DV / 32], float& m, float& l) {
    const int tid = ltid(), lane = tid & 63, r32 = lane & 31, hi = lane >> 5, wid = __builtin_amdgcn_readfirstlane(tid >> 6);
    constexpr int NV = DV / 64, ND = DV / 32;
    constexpr int EPG = (DV == 128) ? 2 : 4;
    volatile LAS float* wsf = (volatile LAS float*)(lds + ATT_WSF) + wid * 64;
    const int NT = S.nctx + (S.t1 - S.t0);
    const int krow = tid >> 3, kch = tid & 7;
    u32x4 sk; u32x4 sv[NV];
#define SB() __builtin_amdgcn_sched_barrier(0)
#define ATT_LOAD(i) do { const int _i = (i); const bf16_t* kp; const bf16_t* vp; \
        if (_i < S.nctx) { kp = S.Kc + (size_t)_i * 64 * PW; vp = S.Vc + _i * 64; } else { const int _t = S.t0 + _i - S.nctx; kp = S.Kl + (size_t)_t * 64 * PW; vp = S.Vl + _t * 64; } \
        sk = *(const u32x4*)(kp + (size_t)krow * PW + kch * 8); \
        _Pragma("unroll") for (int j = 0; j < NV; ++j) { const int idx = tid + 512 * j; sv[j] = *(const u32x4*)(vp + (size_t)(idx >> 3) * MTOT + (idx & 7) * 8); } } while (0)
#define ATT_STORE(kbuf, vbuf) do { *(LAS u32x4*)(lds + (kbuf) * ATT_KB + krow * 144 + kch * 16) = sk; \
        _Pragma("unroll") for (int j = 0; j < NV; ++j) { const int idx = tid + 512 * j; const int c_ = idx & 7; ldsp vq = lds + ATT_VOFF + (vbuf) * ATT_VB + (idx >> 3) * ATT_VS + (c_ >> 1) * 32 + (c_ & 1) * 8; \
            *(LAS u32x2*)(vq) = (u32x2){sv[j].x, sv[j].y}; *(LAS u32x2*)(vq + 16) = (u32x2){sv[j].z, sv[j].w}; } } while (0)
#define ATT_VLOAD(dst, Vb_, dblk) do { _Pragma("unroll") for (int j = 0; j < 4; ++j) dst[j] = *(const LAS bf16x8*)((Vb_) + (32 * (dblk) + r32) * ATT_VS + (16 * j + 8 * hi) * 2); } while (0)
#define ATT_KLOAD(Kb_) do { _Pragma("unroll") for (int d0 = 0; d0 < 4; ++d0) { kf[2 * d0] = *(const LAS bf16x8*)((Kb_) + r32 * 144 + (d0 * 16 + hi * 8) * 2); \
            kf[2 * d0 + 1] = *(const LAS bf16x8*)((Kb_) + (32 + r32) * 144 + (d0 * 16 + hi * 8) * 2); } } while (0)
#define EL(X0, X1, e) ((e) < 16 ? X0[(e) & 15] : X1[(e) & 15])
#define ATT_QK(C0, C1, P0, P1, Kb_, PREV) do { bf16x8 kf[8]; ATT_KLOAD(Kb_); SB(); float sacc = 0.f; \
        _Pragma("unroll") for (int q = 0; q < 8; ++q) { \
            if (q == 0) C0 = MFMA32(kf[0], qr[0], zero16); else if (q == 1) C1 = MFMA32(kf[1], qr[0], zero16); \
            else if ((q & 1) == 0) C0 = MFMA32(kf[q], qr[q >> 1], C0); else C1 = MFMA32(kf[q], qr[q >> 1], C1); \
            if (PREV) { sacc += EL(P0, P1, 4 * q) + EL(P0, P1, 4 * q + 1); sacc += EL(P0, P1, 4 * q + 2) + EL(P0, P1, 4 * q + 3); \
                pw[2 * q] = cvt_pk_bf16(EL(P0, P1, 4 * q), EL(P0, P1, 4 * q + 1)); pw[2 * q + 1] = cvt_pk_bf16(EL(P0, P1, 4 * q + 2), EL(P0, P1, 4 * q + 3)); } \
            SB(); } \
        if (PREV) l += sacc; } while (0)
#define PAF(j) __builtin_bit_cast(bf16x8, (u32x4){pw[4 * (j)], pw[4 * (j) + 1], pw[4 * (j) + 2], pw[4 * (j) + 3]})
#define ATT_MAX(C0, C1, I) do { \
        if (WIN && (I) >= S.nctx) { const int kp0 = (S.t0 + (I) - S.nctx) * 64 - qpos; \
            _Pragma("unroll") for (int r = 0; r < 16; ++r) { const int dlt = kp0 + crow(r, hi); if (dlt > 128 || dlt < -128) C0[r] = -1e30f; if (dlt + 32 > 128 || dlt + 32 < -128) C1[r] = -1e30f; } } \
        asm volatile("s_nop 15\n\ts_nop 7" : "+v"(C0), "+v"(C1)); \
        float mx = max3f(C0[0], C0[1], C1[0]), mx2 = max3f(C0[2], C0[3], C1[1]); mx = max3f(mx, C1[2], C1[3]); \
        _Pragma("unroll") for (int r = 4; r < 16; r += 4) { mx = max3f(mx, C0[r], C0[r + 1]); mx2 = max3f(mx2, C0[r + 2], C0[r + 3]); mx = max3f(mx, C1[r], C1[r + 1]); mx2 = max3f(mx2, C1[r + 2], C1[r + 3]); } \
        mx = fmaxf(mx, mx2); mx = fmaxf(mx, __shfl_xor(mx, 32)); \
        mnew = (mx > m + 8.0f) ? mx : m; alpha = __builtin_amdgcn_exp2f(m - mnew); } while (0)
#define ATT_EXP(C0, C1, e) do { if ((e) < 16) C0[(e) & 15] = __builtin_amdgcn_exp2f(C0[(e) & 15] - mnew); else C1[(e) & 15] = __builtin_amdgcn_exp2f(C1[(e) & 15] - mnew); } while (0)
#define ATT_PVX(C0, C1, Vb_, DOEXP) do { bf16x8 va[4], vb[4]; ATT_VLOAD(va, Vb_, 0); ATT_VLOAD(vb, Vb_, 1); SB(); \
        _Pragma("unroll") for (int j = 0; j < 4; ++j) { o[0] = MFMA32(PAF(j), va[j], o[0]); if (DOEXP) { _Pragma("unroll") for (int x = 0; x < EPG; ++x) ATT_EXP(C0, C1, EPG * j + x); asm volatile("" : "+v"(C0), "+v"(C1)); } SB(); } \
        if constexpr (DV == 128) { ATT_VLOAD(va, Vb_, 2); SB(); } \
        _Pragma("unroll") for (int j = 0; j < 4; ++j) { o[1] = MFMA32(PAF(j), vb[j], o[1]); if (DOEXP) { _Pragma("unroll") for (int x = 0; x < EPG; ++x) ATT_EXP(C0, C1, EPG * (4 + j) + x); asm volatile("" : "+v"(C0), "+v"(C1)); } SB(); } \
        if constexpr (DV == 128) { ATT_VLOAD(vb, Vb_, 3); SB(); \
            _Pragma("unroll") for (int j = 0; j < 4; ++j) { o[2] = MFMA32(PAF(j), va[j], o[2]); if (DOEXP) { _Pragma("unroll") for (int x = 0; x < EPG; ++x) ATT_EXP(C0, C1, EPG * (8 + j) + x); asm volatile("" : "+v"(C0), "+v"(C1)); } SB(); } \
            _Pragma("unroll") for (int j = 0; j < 4; ++j) { o[3] = MFMA32(PAF(j), vb[j], o[3]); if (DOEXP) { _Pragma("unroll") for (int x = 0; x < EPG; ++x) ATT_EXP(C0, C1, EPG * (12 + j) + x); asm volatile("" : "+v"(C0), "+v"(C1)); } SB(); } } } while (0)
#define ATT_RESCALE() do { if (__any(alpha != 1.0f)) { if (hi == 0) wsf[r32] = alpha; \
            _Pragma("unroll") for (int r = 0; r < 16; ++r) { const float a_ = wsf[crow(r, hi)]; _Pragma("unroll") for (int d = 0; d < ND; ++d) o[d][r] *= a_; } \
            l *= alpha; } m = mnew; } while (0)
#define ATT_TAIL(I) do { if (more) ATT_STORE(((I) + 1) & 1, vnext); __syncthreads(); vprev = vcur; vcur = vnext; vnext = (vnext == 2) ? 0 : vnext + 1; } while (0)
#define ATT_ITER(C0, C1, P0, P1, I) do { const bool more = ((I) + 1) < NT; if (more) ATT_LOAD((I) + 1); \
        ldsp Kb_ = lds + ((I) & 1) * ATT_KB; ldsp Vp_ = lds + ATT_VOFF + vprev * ATT_VB; \
        ATT_QK(C0, C1, P0, P1, Kb_, true); \
        ATT_MAX(C0, C1, I); SB(); \
        ATT_PVX(C0, C1, Vp_, true); \
        ATT_RESCALE(); ATT_TAIL(I); } while (0)
    f32x16 zero16;
#pragma unroll
    for (int r = 0; r < 16; ++r) zero16[r] = 0.f;
    f32x16 pA0, pA1, pB0, pB1;
    unsigned pw[16];
    float mnew, alpha;
    int vprev = 2, vcur = 0, vnext = 1;
    ATT_LOAD(0); ATT_STORE(0, 0);
    __syncthreads();
    {
        const bool more = 1 < NT; if (more) ATT_LOAD(1);
        ldsp Kb_ = lds;
        ATT_QK(pA0, pA1, pB0, pB1, Kb_, false);
        ATT_MAX(pA0, pA1, 0);
#pragma unroll
        for (int e = 0; e < 32; ++e) ATT_EXP(pA0, pA1, e);
        ATT_RESCALE(); ATT_TAIL(0);
    }
    int i = 1;
    for (; i + 1 < NT; i += 2) { ATT_ITER(pB0, pB1, pA0, pA1, i); ATT_ITER(pA0, pA1, pB0, pB1, i + 1); }
    if (i < NT) {
        ATT_ITER(pB0, pB1, pA0, pA1, i);
        float sacc = 0.f;
#pragma unroll
        for (int q = 0; q < 8; ++q) { sacc += EL(pB0, pB1, 4 * q) + EL(pB0, pB1, 4 * q + 1); sacc += EL(pB0, pB1, 4 * q + 2) + EL(pB0, pB1, 4 * q + 3);
            pw[2 * q] = cvt_pk_bf16(EL(pB0, pB1, 4 * q), EL(pB0, pB1, 4 * q + 1)); pw[2 * q + 1] = cvt_pk_bf16(EL(pB0, pB1, 4 * q + 2), EL(pB0, pB1, 4 * q + 3)); }
        l += sacc;
    } else {
        float sacc = 0.f;
#pragma unroll
        for (int q = 0; q < 8; ++q) { sacc += EL(pA0, pA1, 4 * q) + EL(pA0, pA1, 4 * q + 1); sacc += EL(pA0, pA1, 4 * q + 2) + EL(pA0, pA1, 4 * q + 3);
            pw[2 * q] = cvt_pk_bf16(EL(pA0, pA1, 4 * q), EL(pA0, pA1, 4 * q + 1)); pw[2 * q + 1] = cvt_pk_bf16(EL(pA0, pA1, 4 * q + 2), EL(pA0, pA1, 4 * q + 3)); }
        l += sacc;
    }
    { ldsp Vp_ = lds + ATT_VOFF + vprev * ATT_VB; SB(); ATT_PVX(pA0, pA1, Vp_, false); }
    __syncthreads();
#undef SB
#undef ATT_LOAD
#undef ATT_STORE
#undef ATT_VLOAD
#undef ATT_KLOAD
#undef EL
#undef ATT_QK
#undef PAF
#undef ATT_MAX
#undef ATT_EXP
#undef ATT_PVX
#undef ATT_RESCALE
#undef ATT_TAIL
#undef ATT_ITER
}
template <int ND>
__device__ __forceinline__ void attn_normalize(ldsp lds, f32x16 (&o)[ND], float l) {
    const int tid = ltid(), lane = tid & 63, r32 = lane & 31, hi = lane >> 5, wid = tid >> 6;
    volatile LAS float* wsf = (volatile LAS float*)(lds + ATT_WSF) + wid * 64;
    const float lt = l + __shfl_xor(l, 32);
    if (hi == 0) wsf[r32] = 1.0f / lt;
#pragma unroll
    for (int r = 0; r < 16; ++r) { const float a = wsf[crow(r, hi)];
#pragma unroll
        for (int d = 0; d < ND; ++d) o[d][r] *= a; }
}
__device__ __forceinline__ void load_q(bf16x8 (&qr)[4], const bf16_t* Qp  ) {
    const int lane = ltid() & 63, hi = lane >> 5;
#pragma unroll
    for (int d0 = 0; d0 < 4; ++d0) qr[d0] = *(const bf16x8*)(Qp + d0 * 16 + hi * 8);
}

__device__ __forceinline__ void mixb_unit(ldsp lds, const bf16_t* P, const bf16_t* PT, float* stash, bf16_t* mix, const float* subg, float lam, float lam_init,
                                          int b, int h, int qrow0, bool ctx_only) {
    const int tid = ltid(), lane = tid & 63, r32 = lane & 31, hi = lane >> 5, wid = tid >> 6;
    const int rowq = qrow0 + 32 * wid;
    f32x16 o[4];
#pragma unroll 1
    for (int c = 0; c < 2; ++c) {
        bf16x8 qr[4];
        load_q(qr, P + (size_t)(rowq + r32) * PW + PC_QB + 128 * h + 64 * c);
        AttnSeg S;
        S.Kc = P + (size_t)(NLAT + b * CTXL) * PW + PC_KB + 128 * h + 64 * c;
        S.Kl = P + (size_t)(b * SEQ) * PW + PC_KB + 128 * h + 64 * c;
        S.Vc = PT + (size_t)(PR_VB + 128 * h) * MTOT + NLAT + b * CTXL;
        S.Vl = PT + (size_t)(PR_VB + 128 * h) * MTOT + b * SEQ;
        S.nctx = 4; S.t0 = 0; S.t1 = ctx_only ? 0 : (SEQ / 64);
#pragma unroll
        for (int d = 0; d < 4; ++d)
#pragma unroll
            for (int r = 0; r < 16; ++r) o[d][r] = 0.f;
        float m = -1e30f, l = 0.f;
        attn_pass<128, false>(lds, S, qr, 0, o, m, l);
        attn_normalize<4>(lds, o, l);
        if (c == 0) {
            int rq = rowq * 512 + h * 128 + r32 + 4 * hi * 512; asm volatile("" : "+v"(rq));
            float* sp = stash + rq;
#pragma unroll
            for (int d = 0; d < 4; ++d)
#pragma unroll
                for (int r = 0; r < 16; ++r) sp[((r & 3) + 8 * (r >> 2)) * 512 + 32 * d] = o[d][r];
        }
    }
    float gv[4];
#pragma unroll
    for (int d = 0; d < 4; ++d) gv[d] = subg[32 * d + r32] * (1.0f - lam_init);
    int rq2 = rowq + 4 * hi; asm volatile("" : "+v"(rq2));
    const float* sp2 = stash + (size_t)rq2 * 512 + h * 128 + r32;
    bf16_t* mp2 = mix + (size_t)rq2 * DM + 256 + 128 * h + r32;
    float ss[16];
#pragma unroll
    for (int r = 0; r < 16; ++r) {
        const int ro = (r & 3) + 8 * (r >> 2);
        float s = 0.f;
#pragma unroll
        for (int d = 0; d < 4; ++d) { o[d][r] = sp2[ro * 512 + 32 * d] - lam * o[d][r]; s += o[d][r] * o[d][r]; }
        ss[r] = s;
    }
#pragma unroll
    for (int st = 1; st < 32; st <<= 1) {
#pragma unroll
        for (int r = 0; r < 16; ++r) ss[r] += __shfl_xor(ss[r], st);
    }
#pragma unroll
    for (int r = 0; r < 16; ++r) {
        const int ro = (r & 3) + 8 * (r >> 2);
        const float rstd = rsqrtf(ss[r] * (1.0f / 128.0f) + EPS);
#pragma unroll
        for (int d = 0; d < 4; ++d) { const float y = o[d][r] * rstd * gv[d]; mp2[ro * DM + 32 * d] = (bf16_t)(cvt_pk_bf16(y, 0.f) & 0xffffu); }
    }
}
__device__ __forceinline__ void mixa_unit(ldsp lds, const bf16_t* P, const bf16_t* PT, bf16_t* mix, float sink, int b, int qh, int qrow0, int q0  , bool ctx_only) {
    const int tid = ltid(), lane = tid & 63, r32 = lane & 31, hi = lane >> 5, wid = tid >> 6;
    const int rowq = qrow0 + 32 * wid; const int g = qh >> 1;
    bf16x8 qr[4];
    load_q(qr, P + (size_t)(rowq + r32) * PW + PC_QA + 64 * qh);
    AttnSeg S;
    S.Kc = P + (size_t)(NLAT + b * CTXL) * PW + PC_KA + 64 * g;
    S.Kl = P + (size_t)(b * SEQ) * PW + PC_KA + 64 * g;
    S.Vc = PT + (size_t)(PR_VA + 64 * g) * MTOT + NLAT + b * CTXL;
    S.Vl = PT + (size_t)(PR_VA + 64 * g) * MTOT + b * SEQ;
    S.nctx = 4;
    if (ctx_only) { S.t0 = 0; S.t1 = 0; }
    else { const int lo = q0 - 128, hi_ = q0 + 256 + 128; S.t0 = (lo < 0 ? 0 : lo) / 64; S.t1 = (hi_ > SEQ ? SEQ : hi_) / 64; }
    f32x16 o[2];
#pragma unroll
    for (int d = 0; d < 2; ++d)
#pragma unroll
        for (int r = 0; r < 16; ++r) o[d][r] = 0.f;
    float m = sink * LOG2E, l = (hi == 0) ? 1.0f : 0.0f;
    attn_pass<64, true>(lds, S, qr, q0 + 32 * wid + r32, o, m, l);
    attn_normalize<2>(lds, o, l);
#pragma unroll
    for (int r = 0; r < 16; ++r) { const size_t row = (size_t)(rowq + crow(r, hi));
#pragma unroll
        for (int d = 0; d < 2; ++d) mix[row * DM + 64 * qh + 32 * d + r32] = (bf16_t)(cvt_pk_bf16(o[d][r], 0.f) & 0xffffu); }
}
__device__ __forceinline__ int chunk_row(int b, int cc) { return cc < 2 ? NLAT + b * CTXL + 128 * cc : b * SEQ + 128 * (cc - 2); }
__device__ __forceinline__ void r1_unit(const bf16_t* P, const bf16_t* PT, float* KV, const float* lg, int b, int h, int cc) {
    const int lane = ltid() & 63, r32 = lane & 31, hi = lane >> 5;
    const int tok0 = chunk_row(b, cc);
    const float lgf = lg[h], lgb = lg[4 + h];
    f32x16 of[2], ob[2];
#pragma unroll
    for (int d = 0; d < 2; ++d)
#pragma unroll
        for (int r = 0; r < 16; ++r) { of[d][r] = 0.f; ob[d][r] = 0.f; }
#pragma unroll 2
    for (int kb = 0; kb < 8; ++kb) {
        float kf[8], kk[8];
#pragma unroll
        for (int i = 0; i < 8; ++i) {
            const int key = 16 * kb + 8 * hi + i;
            const float kv = bf2f(P[(size_t)(tok0 + key) * PW + PC_KR + 32 * h + r32]);
            kf[i] = kv * __builtin_amdgcn_exp2f(lgf * (float)(127 - key));
            kk[i] = kv * __builtin_amdgcn_exp2f(lgb * (float)key);
        }
        u32x4 wf, wb;
        wf.x = cvt_pk_bf16(kf[0], kf[1]); wf.y = cvt_pk_bf16(kf[2], kf[3]); wf.z = cvt_pk_bf16(kf[4], kf[5]); wf.w = cvt_pk_bf16(kf[6], kf[7]);
        wb.x = cvt_pk_bf16(kk[0], kk[1]); wb.y = cvt_pk_bf16(kk[2], kk[3]); wb.z = cvt_pk_bf16(kk[4], kk[5]); wb.w = cvt_pk_bf16(kk[6], kk[7]);
        const bf16x8 bfv = __builtin_bit_cast(bf16x8, wf), bbv = __builtin_bit_cast(bf16x8, wb);
#pragma unroll
        for (int d = 0; d < 2; ++d) {
            const bf16x8 av = *(const bf16x8*)(PT + (size_t)(PR_VR + 64 * h + 32 * d + r32) * MTOT + tok0 + 16 * kb + 8 * hi);
            of[d] = MFMA32(av, bfv, of[d]); ob[d] = MFMA32(av, bbv, ob[d]);
        }
    }
    float* kvp = KV + ((size_t)((b * 4 + h) * NCH + cc) * 2) * 2048;
#pragma unroll
    for (int d = 0; d < 2; ++d)
#pragma unroll
        for (int r = 0; r < 16; ++r) { const int idx = (32 * d + crow(r, hi)) * 32 + r32; kvp[idx] = of[d][r]; kvp[2048 + idx] = ob[d][r]; }
}
__device__ __forceinline__ void r2_phase(const float* KV, float* ST, const float* lg, int G) {
    for (int t = lbid() * 512 + ltid(); t < 16 * 2 * 2048; t += G * 512) {
        const int e = t & 2047, dir = (t >> 11) & 1, bh = t >> 12, h = bh & 3;
        const float dc = __builtin_amdgcn_exp2f(lg[dir * 4 + h] * 128.0f);
        const float* kv = KV + (size_t)bh * NCH * 4096 + dir * 2048 + e;
        float* st = ST + (size_t)bh * NCH * 4096 + dir * 2048 + e;
        float s = 0.f;
#pragma unroll 1
        for (int g0 = 0; g0 < NCH; g0 += 33) {
            float kvv[33];
#pragma unroll
            for (int q = 0; q < 33; ++q) {
                const int sidx = g0 + q;
                const int cc = (dir == 0) ? sidx : ((sidx < 2) ? (1 - sidx) : (NCH + 1 - sidx));
                kvv[q] = kv[(size_t)cc * 4096];
            }
#pragma unroll
            for (int q = 0; q < 33; ++q) {
                const int sidx = g0 + q;
                const int cc = (dir == 0) ? sidx : ((sidx < 2) ? (1 - sidx) : (NCH + 1 - sidx));
                st[(size_t)cc * 4096] = s; s = dc * s + kvv[q];
            }
        }
    }
}
__device__ __forceinline__ bf16x8 scale_bf16x8(bf16x8 v, float s) {
    const u32x4 w = __builtin_bit_cast(u32x4, v); u32x4 o;
    o.x = cvt_pk_bf16(bflo(w.x) * s, bfhi(w.x) * s); o.y = cvt_pk_bf16(bflo(w.y) * s, bfhi(w.y) * s);
    o.z = cvt_pk_bf16(bflo(w.z) * s, bfhi(w.z) * s); o.w = cvt_pk_bf16(bflo(w.w) * s, bfhi(w.w) * s);
    return __builtin_bit_cast(bf16x8, o);
}
__device__ __forceinline__ void r3_unit(ldsp lds, const bf16_t* P, const bf16_t* PT, const float* ST, bf16_t* mix, const float* lg, int b, int h, int blk, bool is_ctx) {
    const int tid = ltid(), lane = tid & 63, r32 = lane & 31, hi = lane >> 5, wid = tid >> 6;
    const int cw = 2 * blk + (wid >> 2), cc = is_ctx ? cw : cw + 2, i0 = 32 * (wid & 3);
    const int tok0 = chunk_row(b, cc);
    const float lgf = lg[h], lgb = lg[4 + h];
    constexpr int R3_KS = 80, R3_KC = 128 * R3_KS, R3_VS = 272, R3_VC = 64 * R3_VS, R3_VOFF = 2 * R3_KC;
    {
        const int cc0 = is_ctx ? 2 * blk : 2 * blk + 2;
        u32x4 kreg[2], vreg[4];
#pragma unroll
        for (int j = 0; j < 2; ++j) { const int p = tid + 512 * j, ch = p >> 9, row = (p >> 2) & 127, part = p & 3;
            kreg[j] = *(const u32x4*)(P + (size_t)(chunk_row(b, cc0 + ch) + row) * PW + PC_KR + 32 * h + part * 8); }
#pragma unroll
        for (int j = 0; j < 4; ++j) { const int p = tid + 512 * j, ch = p >> 10, row = (p >> 4) & 63, part = p & 15;
            vreg[j] = *(const u32x4*)(PT + (size_t)(PR_VR + 64 * h + row) * MTOT + chunk_row(b, cc0 + ch) + part * 8); }
#pragma unroll
        for (int j = 0; j < 2; ++j) { const int p = tid + 512 * j, ch = p >> 9, row = (p >> 2) & 127, part = p & 3;
            *(LAS u32x4*)(lds + ch * R3_KC + row * R3_KS + part * 16) = kreg[j]; }
#pragma unroll
        for (int j = 0; j < 4; ++j) { const int p = tid + 512 * j, ch = p >> 10, row = (p >> 4) & 63, part = p & 15;
            *(LAS u32x4*)(lds + R3_VOFF + ch * R3_VC + row * R3_VS + part * 16) = vreg[j]; }
    }
    __syncthreads();
    ldsp Kl = lds + (wid >> 2) * R3_KC; ldsp Vl = lds + R3_VOFF + (wid >> 2) * R3_VC;
    bf16x8 q2[2];
#pragma unroll
    for (int d0 = 0; d0 < 2; ++d0) q2[d0] = *(const bf16x8*)(P + (size_t)(tok0 + i0 + r32) * PW + PC_QR + 32 * h + 16 * d0 + 8 * hi);
    f32x16 o[2];
#pragma unroll
    for (int d = 0; d < 2; ++d)
#pragma unroll
        for (int r = 0; r < 16; ++r) o[d][r] = 0.f;
    const int qi = i0 + r32;
#pragma unroll 1
    for (int kb = 0; kb < 4; ++kb) {
        f32x16 p;
#pragma unroll
        for (int r = 0; r < 16; ++r) p[r] = 0.f;
#pragma unroll
        for (int d0 = 0; d0 < 2; ++d0) {
            const bf16x8 kf = *(const LAS bf16x8*)(Kl + (32 * kb + r32) * R3_KS + (16 * d0 + 8 * hi) * 2);
            p = MFMA32(kf, q2[d0], p);
        }
#pragma unroll
        for (int r = 0; r < 16; ++r) {
            const int dlt = qi - (32 * kb + crow(r, hi));
            const float w = dlt >= 0 ? __builtin_amdgcn_exp2f(lgf * (float)dlt) : __builtin_amdgcn_exp2f(lgb * (float)(-dlt));
            p[r] *= w;
        }
        u32x4 w0, w1;
        w0.x = cvt_pk_bf16(p[0], p[1]); w0.y = cvt_pk_bf16(p[2], p[3]); w0.z = cvt_pk_bf16(p[4], p[5]); w0.w = cvt_pk_bf16(p[6], p[7]);
        w1.x = cvt_pk_bf16(p[8], p[9]); w1.y = cvt_pk_bf16(p[10], p[11]); w1.z = cvt_pk_bf16(p[12], p[13]); w1.w = cvt_pk_bf16(p[14], p[15]);
        const bf16x8 pa0 = __builtin_bit_cast(bf16x8, w0), pa1 = __builtin_bit_cast(bf16x8, w1);
#pragma unroll
        for (int d = 0; d < 2; ++d)
#pragma unroll
            for (int jj = 0; jj < 2; ++jj) {
                ldsp vp = Vl + (32 * d + r32) * R3_VS + (32 * kb + 16 * jj + 4 * hi) * 2;
                const s16x4 lo = *(const LAS s16x4*)(vp), h4 = *(const LAS s16x4*)(vp + 16);
                const bf16x8 vf = (bf16x8){lo[0], lo[1], lo[2], lo[3], h4[0], h4[1], h4[2], h4[3]};
                o[d] = MFMA32(jj == 0 ? pa0 : pa1, vf, o[d]);
            }
    }
#pragma unroll
    for (int dir = 0; dir < 2; ++dir) {
        const float s = dir == 0 ? __builtin_amdgcn_exp2f(lgf * (float)(qi + 1)) : __builtin_amdgcn_exp2f(lgb * (float)(128 - qi));
        const float* stp = ST + ((size_t)((b * 4 + h) * NCH + cc) * 2 + dir) * 2048;
#pragma unroll
        for (int d0 = 0; d0 < 2; ++d0) {
            const bf16x8 qs = scale_bf16x8(q2[d0], s);
#pragma unroll
            for (int d = 0; d < 2; ++d) {
                const float* sp = stp + (32 * d + r32) * 32 + 16 * d0 + 8 * hi;
                const f32x4 a = *(const f32x4*)(sp), c = *(const f32x4*)(sp + 4);
                u32x4 w; w.x = cvt_pk_bf16(a[0], a[1]); w.y = cvt_pk_bf16(a[2], a[3]); w.z = cvt_pk_bf16(c[0], c[1]); w.w = cvt_pk_bf16(c[2], c[3]);
                o[d] = MFMA32(qs, __builtin_bit_cast(bf16x8, w), o[d]);
            }
        }
    }
    float s1[16], q1[16];
#pragma unroll
    for (int r = 0; r < 16; ++r) s1[r] = o[0][r] + o[1][r];
#pragma unroll
    for (int st = 1; st < 32; st <<= 1) {
#pragma unroll
        for (int r = 0; r < 16; ++r) s1[r] += __shfl_xor(s1[r], st);
    }
#pragma unroll
    for (int r = 0; r < 16; ++r) { const float mean = s1[r] * (1.0f / 64.0f); o[0][r] -= mean; o[1][r] -= mean; q1[r] = o[0][r] * o[0][r] + o[1][r] * o[1][r]; }
#pragma unroll
    for (int st = 1; st < 32; st <<= 1) {
#pragma unroll
        for (int r = 0; r < 16; ++r) q1[r] += __shfl_xor(q1[r], st);
    }
    float gg0[16], gg1[16];
    {
        const bf16_t* gp0; const bf16_t* gp1; size_t gstride;
        if (h < 2) { gp0 = P + (size_t)(tok0 + i0 + 4 * hi) * PW + PC_GR + 64 * h + r32; gp1 = gp0 + 32; gstride = PW; }
        else { gp0 = PT + (size_t)(PR_GR2 + 64 * (h - 2) + r32) * MTOT + tok0 + i0 + 4 * hi; gp1 = gp0 + (size_t)32 * MTOT; gstride = 1; }
#pragma unroll
        for (int r = 0; r < 16; ++r) { const size_t ro = (size_t)((r & 3) + 8 * (r >> 2)) * gstride; gg0[r] = bf2f(gp0[ro]); gg1[r] = bf2f(gp1[ro]); }
    }
#pragma unroll
    for (int r = 0; r < 16; ++r) {
        const float rstd = rsqrtf(q1[r] * (1.0f / 64.0f) + EPS);
        const size_t row = (size_t)(tok0 + i0 + crow(r, hi));
        mix[row * DM + 768 + 64 * h + r32] = (bf16_t)(cvt_pk_bf16(silu_f(gg0[r]) * o[0][r] * rstd, 0.f) & 0xffffu);
        mix[row * DM + 768 + 64 * h + 32 + r32] = (bf16_t)(cvt_pk_bf16(silu_f(gg1[r]) * o[1][r] * rstd, 0.f) & 0xffffu);
    }
    __syncthreads();
}

#ifndef PH_PREP
#define PH_PREP 1
#endif
#ifndef PH_NORM
#define PH_NORM 1
#endif
#ifndef PH_IN1
#define PH_IN1 1
#endif
#ifndef PH_IN2
#define PH_IN2 1
#endif
#ifndef PH_R1
#define PH_R1 1
#endif
#ifndef PH_R2
#define PH_R2 1
#endif
#ifndef PH_MIX
#define PH_MIX 1
#endif
#ifndef PH_OUT
#define PH_OUT 1
#endif
#ifndef PH_UP
#define PH_UP 1
#endif
#ifndef PH_CONV
#define PH_CONV 1
#endif
#ifndef PH_DOWN
#define PH_DOWN 1
#endif
#ifndef PH_FIN
#define PH_FIN 1
#endif
__device__ __forceinline__ void mix_phase(ldsp lds, KArgs a, int l, int G) {
    unsigned char* ws = a->ws;
    const bf16_t* P = (const bf16_t*)(ws + WS_P); const bf16_t* PT = (const bf16_t*)(ws + WS_PT);
    bf16_t* mix = (bf16_t*)(ws + WS_MIX); float* stash = a->out;
    const float* ST = (const float*)(ws + WS_ST);
    const float* scal = (const float*)(ws + WS_SCAL);
    const float lam = scal[l], lam_init = scal[2 + l];
    const float* lg = scal + 8 + l * 8;
    const int nc = (l == 0) ? 16 : 0;
    const int total = 3 * (512 + nc);
    for (int u = lbid(); u < total; u += G) {
        int v = u; int kind = 0;
        if (v >= 512 + nc) { v -= 512 + nc; kind = 1; if (v >= 512 + nc) { v -= 512 + nc; kind = 2; } }
        const bool ctx = v >= 512; if (ctx) v -= 512;
        int b, hh, qb;
        if (ctx) { b = v >> 2; hh = v & 3; qb = 0; }
        else {
            int vv = v;
            if (G == 256) { const int x = v & 7, y = (v >> 3) & 31, rnd = v >> 8; vv = (x + 8 * rnd) * 32 + y; }
            b = vv >> 7; hh = (vv >> 5) & 3; qb = vv & 31;
        }
        const int qrow0 = ctx ? NLAT + b * CTXL : b * SEQ + qb * 256;
#ifndef NO_MB
        if (kind == 0) mixb_unit(lds, P, PT, stash, mix, a->in[I_SUBG] + l * 128, lam, lam_init, b, hh, qrow0, ctx);
#endif
#ifndef NO_MA
        if (kind == 1) mixa_unit(lds, P, PT, mix, a->in[I_SINK][l * 4 + hh], b, hh, qrow0, qb * 256, ctx);
#endif
#ifndef NO_MR
        if (kind == 2) r3_unit(lds, P, PT, ST, mix, lg, b, hh, qb, ctx);
#endif
    }
}


enum { K_PREP = 0, K_NORM1, K_GEMM_IN, K_GEMM_PT, K_R1, K_R2, K_MIX, K_GEMM_OUT, K_NORM2, K_UP, K_DOWN, K_FINAL };
constexpr int NPH_L = 10, NPH = 2 + 2 * NPH_L;
__global__ void __launch_bounds__(512, 2) fwd_megakernel(Args a_unused) {
    extern __shared__ __attribute__((aligned(16))) unsigned char lds_raw[];
    ldsp lds = (ldsp)lds_raw;
    cg::grid_group grid = cg::this_grid();
    const int G = gridDim.x;
    {
        volatile LAS unsigned* st = (volatile LAS unsigned*)(lds + LDS_ST_OFF);
        if (ltid() < 2) st[ltid()] = 0u;
        __syncthreads();
        KArgs a0 = (KArgs)__builtin_amdgcn_kernarg_segment_ptr();
        (void)xcd_barrier_post((unsigned*)(a0->ws + WS_BAR), st);
    }
    if (PH_PREP) {
        KArgs a0 = (KArgs)__builtin_amdgcn_kernarg_segment_ptr();
        asm volatile("" : "+s"(a0));
        prep_phase(a0, lds, G);
        if (G > (1 << 20)) grid.sync();
        { XcdBarrier xb; xb.bar = (unsigned*)(a0->ws + WS_BAR); xb.x = xb_xcc_id(); xb.st = (volatile LAS unsigned*)(lds + LDS_ST_OFF); xcd_barrier(xb); }
    }
#pragma unroll 1
    for (int ph = 1; ph < NPH; ++ph) {
        int kind, l;
        if (ph == 0) { kind = K_PREP; l = 0; } else if (ph == NPH - 1) { kind = K_FINAL; l = 1; } else { l = (ph - 1) / NPH_L; kind = K_NORM1 + (ph - 1) % NPH_L; }
        KArgs a = (KArgs)__builtin_amdgcn_kernarg_segment_ptr();
        asm volatile("" : "+s"(a));
        unsigned char* ws = a->ws;
        float* modv = (float*)(ws + WS_MOD);
        const float* modl = modv + (size_t)l * 5 * NMOD;
        bf16_t* Xb = (bf16_t*)(ws + WS_XBF);
        bf16_t* H = (bf16_t*)(ws + WS_H);
        const bool last = (l == 1);
        const int Mffn = last ? NLAT : MTOT;
        const float* xin_l = (l == 0) ? a->in[I_X] : nullptr; const float* xin_c = (l == 0) ? a->in[I_CTX] : nullptr;
        bool sync = true;
        if (PH_NORM && (kind == K_NORM1 || kind == K_NORM2)) {
            const bool n1 = kind == K_NORM1;
            norm_phase(n1 ? xin_l : nullptr, n1 ? xin_c : nullptr, Xb, a->in[n1 ? I_N1G : I_N2G] + l * DM, modl, n1 ? 0 : 3, n1 ? 1 : 4, H, n1 ? MTOT : Mffn, G);
        } else if (PH_IN1 && kind == K_GEMM_IN) {
            const float* c64 = (const float*)(ws + WS_ROPE); const float* s64 = c64 + SEQ * 32; const float* c32 = s64 + SEQ * 32; const float* s32 = c32 + SEQ * 16;
            const bf16_t* Wt_in = (const bf16_t*)(ws + WS_WIN) + (size_t)l * 3072 * DM;
            pg8::Gemm g{H, Wt_in, MTOT, PW, DM}; pg8::StaticOrder S; S.init(MTOT, PW, G, lbid());
            EpiInTok E{(bf16_t*)(ws + WS_P), c64, s64, c32, s32};
            pg8::gemm_phase<EpiInTok, pg8::StaticOrder, true, true>(lds, g, S, E);
            sync = false;
        } else if (PH_UP && kind == K_GEMM_PT) {
            const bf16_t* Wt_in = (const bf16_t*)(ws + WS_WIN) + (size_t)l * 3072 * DM;
            pg8::Gemm g{Wt_in + (size_t)PW * DM, H, PTR, MTOT, DM}; EpiStoreBf16 E{(bf16_t*)(ws + WS_PT), MTOT};
            pg8::StaticOrder S; S.init(g.M, g.N, G, (lbid() + G - ((MTOT / 256) * (PW / 256)) % G) % G);
            pg8::gemm_phase<EpiStoreBf16, pg8::StaticOrder, true, true>(lds, g, S, E);
        } else if (PH_UP && kind == K_UP) {
            const bf16_t* Wt_up = (const bf16_t*)(ws + WS_WUP) + (size_t)l * NUP * DM;
            const int ntile = (Mffn + 247) / 248;
            pg8::Gemm g{H - DM, Wt_up, ntile * 256, NUP, DM};
            EpiUpConv E{(bf16_t*)(ws + WS_A), (const float*)(ws + WS_CWP) + (size_t)l * DFF * 8, Mffn};
            pg8::StaticOrder S; S.init(g.M, g.N, G, lbid());
            pg8::gemm_phase<EpiUpConv, pg8::StaticOrder, true, true>(lds, g, S, E);
        } else if (PH_R1 && kind == K_R1) {
            const int gw = lbid() * 8 + (ltid() >> 6), NGW = G * 8;
            const float* lg = (const float*)(ws + WS_SCAL) + 8 + l * 8;
            for (int u = gw; u < 16 * NCH; u += NGW) { const int bh = u / NCH, cc = u % NCH; r1_unit((const bf16_t*)(ws + WS_P), (const bf16_t*)(ws + WS_PT), (float*)(ws + WS_KV), lg, bh >> 2, bh & 3, cc); }
        } else if (PH_R2 && kind == K_R2) {
            r2_phase((const float*)(ws + WS_KV), (float*)(ws + WS_ST), (const float*)(ws + WS_SCAL) + 8 + l * 8, G);
        } else if (PH_MIX && kind == K_MIX) {
            mix_phase(lds, a, l, G);
        } else if (PH_OUT && (kind == K_GEMM_OUT || kind == K_DOWN)) {
            pg8::Gemm g; EpiResid E;
            if (kind == K_GEMM_OUT) {
                g = pg8::Gemm{(const bf16_t*)(ws + WS_MIX), (const bf16_t*)(ws + WS_WOUT) + (size_t)l * DM * DM, Mffn, DM, DM};
                E = EpiResid{xin_l, xin_c, Xb, modl + 2 * DM};
            } else {
                g = pg8::Gemm{(const bf16_t*)(ws + WS_A), (const bf16_t*)(ws + WS_WDN) + (size_t)l * DM * DFF, Mffn, DM, DFF};
                E = EpiResid{nullptr, nullptr, Xb, modl + 5 * DM};
            }
            pg8::StaticOrder S; S.init(g.M, g.N, G, lbid());
            pg8::gemm_phase<EpiResid, pg8::StaticOrder, true, true>(lds, g, S, E);
        } else if (PH_FIN && kind == K_FINAL) {
            final_norm_phase(Xb, a->out, a->in[I_FG], G);
            sync = false;
        }
        if (sync) { XcdBarrier xb; xb.bar = (unsigned*)(ws + WS_BAR); xb.x = xb_xcc_id(); xb.st = (volatile LAS unsigned*)(lds + LDS_ST_OFF); xcd_barrier(xb); }
    }
}

extern "C" void kernel_launch(void* const* d_in, const int* in_sizes, int n_in, void* d_out, int out_size, void* d_ws, size_t ws_size, hipStream_t stream) {
    static int grid = 0;
    if (grid == 0) {
        if (n_in != 19 || out_size != NLAT * DM || ws_size < WS_END) { fprintf(stderr, "kernel_launch: unexpected shapes: n_in %d out %d ws %zu (need %zu)\n", n_in, out_size, ws_size, (size_t)WS_END); grid = -1; return; }
        int dev = 0, cus = 0, per_cu = 0;
        if (hipGetDevice(&dev) != hipSuccess || hipDeviceGetAttribute(&cus, hipDeviceAttributeMultiprocessorCount, dev) != hipSuccess) { grid = -1; return; }
        if (hipFuncSetAttribute((const void*)fwd_megakernel, hipFuncAttributeMaxDynamicSharedMemorySize, LDS_BYTES) != hipSuccess) { fprintf(stderr, "kernel_launch: hipFuncSetAttribute failed\n"); grid = -1; return; }
        if (hipOccupancyMaxActiveBlocksPerMultiprocessor(&per_cu, (const void*)fwd_megakernel, 512, LDS_BYTES) != hipSuccess || per_cu < 1) { fprintf(stderr, "kernel_launch: occupancy query says %d\n", per_cu); per_cu = 1; }
        (void)hipGetLastError();
        grid = cus;
    }
    if (grid < 0) return;
    if (hipMemsetAsync((char*)d_ws + WS_BAR, 0, 16384, stream) != hipSuccess) { fprintf(stderr, "memset failed\n"); return; }
    Args a{};
    for (int i = 0; i < 19; ++i) a.in[i] = (const float*)d_in[i];
    a.out = (float*)d_out; a.ws = (unsigned char*)d_ws;
    void* args[] = {&a};
    hipError_t e = hipLaunchCooperativeKernel((const void*)fwd_megakernel, dim3(grid), dim3(512), args, LDS_BYTES, stream);
    if (e != hipSuccess) fprintf(stderr, "cooperative launch failed: %s (grid %d)\n", hipGetErrorString(e), grid);
}
```

```cpp
#include <hip/hip_runtime.h>
#include <hip/hip_cooperative_groups.h>
#include <cstdio>
#include <cstdint>
namespace cg = cooperative_groups;
__device__ __forceinline__ int ltid() { int t = threadIdx.x; asm volatile("" : "+v"(t)); return t; }
__device__ __forceinline__ int lbid() { int t = blockIdx.x; asm volatile("" : "+s"(t)); return t; }
namespace pg8 {
#define PG8_LAS __attribute__((address_space(3)))
typedef unsigned short bf16_t;
typedef short bf16x8 __attribute__((ext_vector_type(8)));
typedef float f32x4 __attribute__((ext_vector_type(4)));
typedef unsigned u32x4 __attribute__((ext_vector_type(4)));
constexpr int BM = 256, BK = 64, HALF = 128, HTB = HALF * BK * 2  , STAGE_BYTES = 8 * HTB, NXCD = 8, WGM = 8;

__host__ __device__ __forceinline__ int lds_byte(int r, int c) { const int st = (r >> 4) * 2 + (c >> 5), rr = r & 15, cc = c & 31, ob = rr * 64 + cc * 2; return st * 1024 + (ob ^ (((ob >> 9) & 1) << 5)); }
__host__ __device__ __forceinline__ void stage_rc(int b, int& R, int& C) { const int st = b / 1024, sb = b % 1024, swz = sb ^ (((sb >> 9) & 1) << 5); R = (st >> 1) * 16 + swz / 64; C = (st & 1) * 32 + (swz % 64) / 2; }
__host__ __device__ __forceinline__ int perm32(int rho) { const int n = rho >> 4, i = rho & 15; return 8 * (i >> 2) + 4 * n + (i & 3); }

struct Unit { int pm, pn; };
struct Gemm { const bf16_t* A; const bf16_t* Bt; int M, N, K; };

struct StaticOrder {
    int nM, nN, nwg, G, c;
    __host__ __device__ void init(int M, int N, int G_, int c_) { nM = M / BM; nN = N / BM; nwg = nM * nN; G = G_; c = c_; }
    __host__ __device__ bool next(int i, Unit& u) const {
        const long L = (long)i * G + c; if (L >= nwg) return false;
        int wgid = (int)L; { const int q = nwg / NXCD, r = nwg % NXCD, xcd = wgid % NXCD, off = wgid / NXCD; wgid = (xcd < r ? xcd * (q + 1) : r * (q + 1) + (xcd - r) * q) + off; }
        const int nig = WGM * nN, gid = wgid / nig, fm = gid * WGM, gsz = (nM - fm) < WGM ? (nM - fm) : WGM;
        u.pm = fm + ((wgid % nig) % gsz); u.pn = (wgid % nig) / gsz; return true;
    }
    __device__ __forceinline__ void a_ready(const Unit&) const {}
    __device__ __forceinline__ void done(const Unit&) const {}
};

__device__ __forceinline__ unsigned cvt_pk_bf16(float lo, float hi) { unsigned r; asm volatile("v_cvt_pk_bf16_f32 %0, %1, %2" : "=v"(r) : "v"(lo), "v"(hi)); return r; }
typedef float f32x2 __attribute__((ext_vector_type(2)));
template <class Epi, class Sched, bool ALIGN_EPI = false, bool SP2 = false>
__device__ __forceinline__ void gemm_phase(PG8_LAS unsigned char* lds, const Gemm g, const Sched& S, const Epi& E) {
    const int tid = ltid(), wid = __builtin_amdgcn_readfirstlane(tid >> 6), lane = tid & 63, wr = wid >> 2, wc = wid & 3, fr = lane & 15, fq = lane >> 4;
    const int K = g.K, nt = K / BK;
    unsigned voffA[2], voffB[2];
#pragma unroll
    for (int i = 0; i < 2; ++i) { int R, C; stage_rc(tid * 16 + i * 8192, R, C); const int Rb = Epi::PERM ? ((R & ~31) + perm32(R & 31)) : R;
        const int Ra = Epi::AREMAP ? ((R >> 6) * 62 + (R & 63)) : R; voffA[i] = (unsigned)(Ra * K + C) * 2u; voffB[i] = (unsigned)(Rb * K + C) * 2u; }
    const size_t kstep = (size_t)(BK * 2);
    const size_t hstep = (size_t)HALF * K * 2;
    const size_t tstep = 2 * hstep;
    const size_t hstepA = Epi::AREMAP ? (size_t)124 * K * 2 : hstep, tstepA = Epi::AREMAP ? (size_t)248 * K * 2 : tstep;
    const unsigned ldsw = (unsigned)wid * 1024u;
    const int aoff = lds_byte(wr * 64 + fr, fq * 8), boff = lds_byte(wc * 32 + fr, fq * 8);
#define PG8_SA(b, h) (((b) * 2 + (h)) * HTB)
#define PG8_SB(b, h) ((4 + (b) * 2 + (h)) * HTB)
#define PG8_STAGE(bufoff, gbase, voff) do { _Pragma("unroll") for (int _i = 0; _i < 2; ++_i) \
        __builtin_amdgcn_global_load_lds((const unsigned*)((const char*)(gbase) + (voff)[_i]), (PG8_LAS unsigned*)(lds + (bufoff) + ldsw + _i * 8192), 16, 0, 0); } while (0)
#define PG8_LDA(dst, b, h) do { _Pragma("unroll") for (int m = 0; m < 4; ++m) _Pragma("unroll") for (int k = 0; k < 2; ++k) dst[m][k] = *(const PG8_LAS bf16x8*)(lds + PG8_SA(b, h) + aoff + m * 2048 + k * 1024); } while (0)
#define PG8_LDB(dst, b, h) do { _Pragma("unroll") for (int n = 0; n < 2; ++n) _Pragma("unroll") for (int k = 0; k < 2; ++k) dst[n][k] = *(const PG8_LAS bf16x8*)(lds + PG8_SB(b, h) + boff + n * 2048 + k * 1024); } while (0)
#define PG8_MMA(ai, bj, At, Bt) do { __builtin_amdgcn_s_setprio(1); _Pragma("unroll") for (int m = 0; m < 4; ++m) _Pragma("unroll") for (int n = 0; n < 2; ++n) _Pragma("unroll") for (int k = 0; k < 2; ++k) \
        acc[ai][bj][m][n] = __builtin_amdgcn_mfma_f32_16x16x32_bf16(Bt[n][k], At[m][k], acc[ai][bj][m][n], 0, 0, 0); __builtin_amdgcn_s_setprio(0); } while (0)
#define PG8_WAIT_V(n) asm volatile("s_waitcnt vmcnt(" #n ")" ::: "memory")
#define PG8_WAIT_L(n) asm volatile("s_waitcnt lgkmcnt(" #n ")" ::: "memory")
#define PG8_BAR __builtin_amdgcn_s_barrier()
#define PG8_SCHED __builtin_amdgcn_sched_barrier(0)
    Unit cur, nxt; int ui = 0;
    if (!S.next(0, cur)) return;
    f32x4 acc[2][2][4][2];
#pragma unroll
    for (int a = 0; a < 2; ++a)
#pragma unroll
        for (int b = 0; b < 2; ++b)
#pragma unroll
            for (int m = 0; m < 4; ++m)
#pragma unroll
                for (int n = 0; n < 2; ++n) acc[a][b][m][n] = (f32x4){0.f, 0.f, 0.f, 0.f};
    bf16x8 At[4][2], B0[2][2], B1[2][2];
    const char* cA = (const char*)g.A + (size_t)cur.pm * tstepA; const char* cB = (const char*)g.Bt + (size_t)cur.pn * tstep;
    S.a_ready(cur);
    if constexpr (SP2) {
        PG8_STAGE(PG8_SB(0, 0), cB, voffB); PG8_STAGE(PG8_SB(0, 1), cB + hstep, voffB); PG8_STAGE(PG8_SA(0, 0), cA, voffA); PG8_STAGE(PG8_SA(0, 1), cA + hstepA, voffA);
        if (wr == 1) PG8_BAR;
        PG8_WAIT_V(2); PG8_BAR;
        PG8_STAGE(PG8_SB(1, 0), cB + kstep, voffB); PG8_STAGE(PG8_SA(1, 0), cA + kstep, voffA); PG8_STAGE(PG8_SB(1, 1), cB + hstep + kstep, voffB);
        PG8_WAIT_V(6); PG8_BAR;
    } else {
        PG8_STAGE(PG8_SB(0, 0), cB, voffB); PG8_STAGE(PG8_SA(0, 0), cA, voffA); PG8_STAGE(PG8_SB(0, 1), cB + hstep, voffB); PG8_STAGE(PG8_SA(0, 1), cA + hstepA, voffA);
        if (wr == 1) PG8_BAR;
        PG8_WAIT_V(4); PG8_BAR;
        PG8_STAGE(PG8_SB(1, 0), cB + kstep, voffB); PG8_STAGE(PG8_SA(1, 0), cA + kstep, voffA); PG8_STAGE(PG8_SB(1, 1), cB + hstep + kstep, voffB);
        PG8_WAIT_V(6); PG8_BAR;
    }
    for (;;) {
        const bool has_next = S.next(ui + 1, nxt);
        const char* nA = has_next ? (const char*)g.A + (size_t)nxt.pm * tstepA : cA; const char* nB = has_next ? (const char*)g.Bt + (size_t)nxt.pn * tstep : cB;
        for (int t = 0; t < nt; t += 2) {
            const bool last = (t == nt - 2);
            const char* a1 = cA + (size_t)(t + 1) * kstep;
            const char* a2 = last ? nA : cA + (size_t)(t + 2) * kstep; const char* b2 = last ? nB : cB + (size_t)(t + 2) * kstep;
            const char* a3 = a2 + kstep; const char* b3 = b2 + kstep;
            if (last && has_next) S.a_ready(nxt);
            if constexpr (SP2) {
            PG8_LDB(B0, 0, 0); PG8_LDB(B1, 0, 1); PG8_SCHED; PG8_LDA(At, 0, 0); PG8_STAGE(PG8_SA(1, 1), a1 + hstepA, voffA);
            PG8_WAIT_V(8); PG8_WAIT_L(0); PG8_BAR; PG8_MMA(0, 0, At, B0); PG8_MMA(0, 1, At, B1); PG8_BAR; PG8_SCHED;
            PG8_LDA(At, 0, 1); PG8_STAGE(PG8_SB(0, 0), b2, voffB); PG8_STAGE(PG8_SB(0, 1), b2 + hstep, voffB); PG8_STAGE(PG8_SA(0, 0), a2, voffA);
            PG8_WAIT_V(8); PG8_WAIT_L(0); PG8_BAR; PG8_MMA(1, 0, At, B0); PG8_MMA(1, 1, At, B1); PG8_BAR; PG8_SCHED;
            PG8_LDB(B0, 1, 0); PG8_LDB(B1, 1, 1); PG8_SCHED; PG8_LDA(At, 1, 0); PG8_STAGE(PG8_SA(0, 1), a2 + hstepA, voffA);
            PG8_WAIT_V(8); PG8_WAIT_L(0); PG8_BAR; PG8_MMA(0, 0, At, B0); PG8_MMA(0, 1, At, B1); PG8_BAR; PG8_SCHED;
            PG8_LDA(At, 1, 1); PG8_STAGE(PG8_SB(1, 0), b3, voffB); PG8_STAGE(PG8_SB(1, 1), b3 + hstep, voffB); PG8_STAGE(PG8_SA(1, 0), a3, voffA);
            PG8_WAIT_V(8); PG8_WAIT_L(0); PG8_BAR; PG8_MMA(1, 0, At, B0); PG8_MMA(1, 1, At, B1); PG8_BAR; PG8_SCHED;
            } else {
            PG8_LDB(B0, 0, 0); PG8_SCHED; PG8_LDA(At, 0, 0); PG8_STAGE(PG8_SA(1, 1), a1 + hstepA, voffA);
            PG8_WAIT_L(8); PG8_BAR; PG8_WAIT_L(0); PG8_MMA(0, 0, At, B0); PG8_BAR; PG8_SCHED;
            PG8_LDB(B1, 0, 1); PG8_STAGE(PG8_SB(0, 0), b2, voffB);
            PG8_BAR; PG8_WAIT_L(0); PG8_MMA(0, 1, At, B1); PG8_BAR;
            PG8_LDA(At, 0, 1); PG8_STAGE(PG8_SA(0, 0), a2, voffA);
            PG8_BAR; PG8_WAIT_L(0); PG8_MMA(1, 0, At, B0); PG8_BAR; PG8_SCHED;
            PG8_STAGE(PG8_SB(0, 1), b2 + hstep, voffB);
            PG8_WAIT_V(6); PG8_BAR; PG8_MMA(1, 1, At, B1); PG8_BAR;
            PG8_LDB(B0, 1, 0); PG8_SCHED; PG8_LDA(At, 1, 0); PG8_STAGE(PG8_SA(0, 1), a2 + hstepA, voffA);
            PG8_WAIT_L(8); PG8_BAR; PG8_WAIT_L(0); PG8_MMA(0, 0, At, B0); PG8_BAR; PG8_SCHED;
            PG8_LDB(B1, 1, 1); PG8_STAGE(PG8_SB(1, 0), b3, voffB);
            PG8_BAR; PG8_WAIT_L(0); PG8_MMA(0, 1, At, B1); PG8_BAR;
            PG8_LDA(At, 1, 1); PG8_STAGE(PG8_SA(1, 0), a3, voffA);
            PG8_BAR; PG8_WAIT_L(0); PG8_MMA(1, 0, At, B0); PG8_BAR; PG8_SCHED;
            PG8_STAGE(PG8_SB(1, 1), b3 + hstep, voffB);
            PG8_WAIT_V(6); PG8_BAR; PG8_MMA(1, 1, At, B1); PG8_BAR;
            }
        }
        if constexpr (ALIGN_EPI) { if (wr == 0) PG8_BAR; }
        if constexpr (!Epi::AFTER_DRAIN) { E(acc, cur, wr, wc, fr, fq); S.done(cur); }
        if (!has_next) break;
#pragma unroll
        for (int a = 0; a < 2; ++a)
#pragma unroll
            for (int b = 0; b < 2; ++b)
#pragma unroll
                for (int m = 0; m < 4; ++m)
#pragma unroll
                    for (int n = 0; n < 2; ++n) acc[a][b][m][n] = (f32x4){0.f, 0.f, 0.f, 0.f};
        cur = nxt; cA = nA; cB = nB; ++ui;
        if constexpr (ALIGN_EPI) { if (wr == 1) PG8_BAR; }
    }
    PG8_WAIT_V(0);
    if constexpr (!ALIGN_EPI) { if (wr == 0) PG8_BAR; }
    PG8_BAR;
    if constexpr (Epi::AFTER_DRAIN) { E.fused(acc, cur, wr, wc, fr, fq, lds, wid, lane); S.done(cur); }
#undef PG8_SA
#undef PG8_SB
#undef PG8_STAGE
#undef PG8_LDA
#undef PG8_LDB
#undef PG8_MMA
#undef PG8_WAIT_V
#undef PG8_WAIT_L
#undef PG8_BAR
#undef PG8_SCHED
}
}
#define LAS __attribute__((address_space(3)))
typedef LAS unsigned char* ldsp;
typedef unsigned short bf16_t;
typedef short bf16x8 __attribute__((ext_vector_type(8)));
typedef short s16x4 __attribute__((ext_vector_type(4)));
typedef float f32x4 __attribute__((ext_vector_type(4)));
typedef float f32x16 __attribute__((ext_vector_type(16)));
typedef unsigned u32x4 __attribute__((ext_vector_type(4)));
typedef unsigned u32x2 __attribute__((ext_vector_type(2)));
typedef float f32x2_t __attribute__((ext_vector_type(2))); typedef __bf16 bf16x2_t __attribute__((ext_vector_type(2)));
__device__ __forceinline__ unsigned cvt_pk_bf16(float lo, float hi) { f32x2_t v = {lo, hi}; bf16x2_t b = __builtin_convertvector(v, bf16x2_t); return __builtin_bit_cast(unsigned, b); }

constexpr int DM = 1024, NBATCH = 4, SEQ = 8192, CTXL = 256;
constexpr int NLAT = NBATCH * SEQ, NCTX = NBATCH * CTXL, MTOT = NLAT + NCTX;
constexpr int PW = 1792;
constexpr int PTR = 1024;
constexpr int DFF = 2816, NUP = 2 * DFF, NMOD = 6 * DM, INW = 2816;
constexpr int NCH = 66;
constexpr float LOG2E = 1.4426950408889634f;
constexpr float C2 = 0.125f * LOG2E;
constexpr float KRS = 0.17677669529663687f;
constexpr float EPS = 1e-6f;
constexpr int PC_QA = 0, PC_KA = 256, PC_QB = 384, PC_KB = 896, PC_QR = 1408, PC_KR = 1536, PC_GR = 1664;
constexpr int PR_VA = 0, PR_VB = 128, PR_VR = 640, PR_GR2 = 896;

constexpr size_t MiB = 1u << 20;
constexpr size_t WS_MOD = 0, WS_SCAL = 256 * 1024, CTL_ZERO = 1 * MiB;
constexpr size_t WS_WIN = 1 * MiB, WS_WOUT = 13 * MiB, WS_WUP = 17 * MiB, WS_WDN = 39 * MiB;
constexpr size_t WS_ROPE = 50 * MiB, WS_XC = 54 * MiB, WS_H = 58 * MiB;
constexpr size_t WS_P = 126 * MiB, WS_PT = 258 * MiB, WS_MIX = 324 * MiB, WS_STASH = 390 * MiB, WS_KV = 456 * MiB, WS_ST = 473 * MiB;
constexpr size_t WS_A = 126 * MiB, WS_END = 490 * MiB;
constexpr size_t WS_XBF = 390 * MiB;
constexpr int LDS_BYTES = 147456;
constexpr int LDS_ST_OFF = 131072 + 256;
constexpr size_t WS_BAR = 512 * 1024;
constexpr size_t WS_CWP = 768 * 1024;

struct Args { const float* in[19]; float* out; unsigned char* ws; };
typedef const __attribute__((address_space(4))) Args* KArgs;
enum { I_X = 0, I_C, I_CTX, I_CCTX, I_WMOD, I_BMOD, I_N1G, I_N2G, I_WIN, I_WOUT, I_SINK, I_DLAM, I_SUBG, I_RDL, I_WUP, I_CONVW, I_CONVB, I_WDN, I_FG };

__device__ __forceinline__ float bf2f(unsigned short b) { return __uint_as_float(((unsigned)b) << 16); }
__device__ __forceinline__ float bflo(unsigned w) { return __uint_as_float(w << 16); }
__device__ __forceinline__ float bfhi(unsigned w) { return __uint_as_float(w & 0xffff0000u); }
__device__ __forceinline__ float wave_sum(float v) {
#pragma unroll
    for (int o = 1; o < 64; o <<= 1) v += __shfl_xor(v, o);
    return v;
}
__device__ __forceinline__ float half_sum(float v) {
#pragma unroll
    for (int o = 1; o < 32; o <<= 1) v += __shfl_xor(v, o);
    return v;
}
__device__ __forceinline__ float silu_f(float x) { return x * __builtin_amdgcn_rcpf(1.f + __builtin_amdgcn_exp2f(-LOG2E * x)); }
__device__ __forceinline__ int crow(int r, int hi) { return (r & 3) + 8 * (r >> 2) + 4 * hi; }
__device__ __forceinline__ int mod_index(int row) { return row < NLAT ? (row >> 13) : 4; }

struct EpiStoreBf16 {
    static constexpr bool PERM = true, AFTER_DRAIN = false, AREMAP = false;
    bf16_t* O; int ldc;
    __device__ __forceinline__ void operator()(const f32x4 (&acc)[2][2][4][2], const pg8::Unit& u, int wr, int wc, int fr, int fq) const {
        const int row0 = u.pm * 256 + wr * 64 + fr, col0 = u.pn * 256 + wc * 32 + 8 * fq;
#pragma unroll
        for (int ai = 0; ai < 2; ++ai)
#pragma unroll
            for (int m = 0; m < 4; ++m) { bf16_t* rowp = O + (size_t)(row0 + ai * 128 + m * 16) * ldc + col0;
#pragma unroll
                for (int bj = 0; bj < 2; ++bj) { const f32x4 v0 = acc[ai][bj][m][0], v1 = acc[ai][bj][m][1];
                    u32x4 w; w.x = cvt_pk_bf16(v0[0], v0[1]); w.y = cvt_pk_bf16(v0[2], v0[3]); w.z = cvt_pk_bf16(v1[0], v1[1]); w.w = cvt_pk_bf16(v1[2], v1[3]);
                    *(u32x4*)(rowp + bj * 128) = w; } }
    }
};
struct EpiInTok {
    static constexpr bool PERM = true, AFTER_DRAIN = false, AREMAP = false;
    bf16_t* P; const float* c64; const float* s64; const float* c32; const float* s32;
    __device__ __forceinline__ void operator()(const f32x4 (&acc)[2][2][4][2], const pg8::Unit& u, int wr, int wc, int fr, int fq) const {
        const int row0 = u.pm * 256 + wr * 64 + fr;
        const bool lat = (u.pm * 256) < NLAT;
#pragma unroll
        for (int bj = 0; bj < 2; ++bj) {
            const int seg = 2 * u.pn + bj, cb = u.pn * 256 + bj * 128 + wc * 32 + 8 * fq;
            const int mode = (seg <= 10) ? 1 : ((seg <= 12) ? 2 : 0);
            const float sc = (seg <= 1 || (seg >= 3 && seg <= 6)) ? C2 : ((seg == 12) ? KRS : 1.f);
#pragma unroll
            for (int ai = 0; ai < 2; ++ai)
#pragma unroll
                for (int m = 0; m < 4; ++m) {
                    const int row = row0 + ai * 128 + m * 16;
                    f32x4 v0 = acc[ai][bj][m][0], v1 = acc[ai][bj][m][1];
                    if (mode != 0 && lat) {
                        const int t = row & (SEQ - 1);
                        f32x4 cs, sn;
                        if (mode == 1) { const int i0 = (cb & 63) >> 1; cs = *(const f32x4*)(c64 + t * 32 + i0); sn = *(const f32x4*)(s64 + t * 32 + i0); }
                        else { const int i0 = (cb & 31) >> 1; cs = *(const f32x4*)(c32 + t * 16 + i0); sn = *(const f32x4*)(s32 + t * 16 + i0); }
                        f32x4 a0, a1;
                        a0[0] = v0[0] * cs[0] - v0[1] * sn[0]; a0[1] = v0[0] * sn[0] + v0[1] * cs[0];
                        a0[2] = v0[2] * cs[1] - v0[3] * sn[1]; a0[3] = v0[2] * sn[1] + v0[3] * cs[1];
                        a1[0] = v1[0] * cs[2] - v1[1] * sn[2]; a1[1] = v1[0] * sn[2] + v1[1] * cs[2];
                        a1[2] = v1[2] * cs[3] - v1[3] * sn[3]; a1[3] = v1[2] * sn[3] + v1[3] * cs[3];
                        v0 = a0; v1 = a1;
                    }
                    v0 = v0 * sc; v1 = v1 * sc;
                    u32x4 w; w.x = cvt_pk_bf16(v0[0], v0[1]); w.y = cvt_pk_bf16(v0[2], v0[3]); w.z = cvt_pk_bf16(v1[0], v1[1]); w.w = cvt_pk_bf16(v1[2], v1[3]);
                    *(u32x4*)(P + (size_t)row * PW + cb) = w;
                }
        }
    }
};
struct EpiResid {
    static constexpr bool PERM = true, AFTER_DRAIN = false, AREMAP = false;
    const float* xin_lat; const float* xin_ctx; bf16_t* Xb; const float* gate;
    __device__ __forceinline__ void operator()(const f32x4 (&acc)[2][2][4][2], const pg8::Unit& u, int wr, int wc, int fr, int fq) const {
        const int rowt = u.pm * 256; const int mi = mod_index(rowt);
        const float* xi = xin_lat ? (rowt < NLAT ? xin_lat + (size_t)rowt * DM : xin_ctx + (size_t)(rowt - NLAT) * DM) : nullptr;
        bf16_t* xo = Xb + (size_t)rowt * DM;
        const int col0 = u.pn * 256 + wc * 32 + 8 * fq;
#pragma unroll
        for (int bj = 0; bj < 2; ++bj) {
            const f32x4 g0 = *(const f32x4*)(gate + (size_t)mi * NMOD + col0 + bj * 128), g1 = *(const f32x4*)(gate + (size_t)mi * NMOD + col0 + bj * 128 + 4);
#pragma unroll
            for (int ai = 0; ai < 2; ++ai)
#pragma unroll
                for (int m = 0; m < 4; ++m) {
                    const size_t off = (size_t)(ai * 128 + wr * 64 + m * 16 + fr) * DM + col0 + bj * 128;
                    f32x4 x0, x1;
                    if (xi) { x0 = *(const f32x4*)(xi + off); x1 = *(const f32x4*)(xi + off + 4); }
                    else { const u32x4 w = *(const u32x4*)(xo + off); x0 = (f32x4){bflo(w.x), bfhi(w.x), bflo(w.y), bfhi(w.y)}; x1 = (f32x4){bflo(w.z), bfhi(w.z), bflo(w.w), bfhi(w.w)}; }
                    const f32x4 y0 = x0 + g0 * acc[ai][bj][m][0], y1 = x1 + g1 * acc[ai][bj][m][1];
                    u32x4 o; o.x = cvt_pk_bf16(y0[0], y0[1]); o.y = cvt_pk_bf16(y0[2], y0[3]); o.z = cvt_pk_bf16(y1[0], y1[1]); o.w = cvt_pk_bf16(y1[2], y1[3]);
                    *(u32x4*)(xo + off) = o;
                }
        }
    }
};

__device__ __forceinline__ float dpp_ror1(float v) { return __int_as_float(__builtin_amdgcn_update_dpp(0, __float_as_int(v), 0x121, 0xf, 0xf, false)); }
__device__ __forceinline__ float dpp_ror15(float v) { return __int_as_float(__builtin_amdgcn_update_dpp(0, __float_as_int(v), 0x12F, 0xf, 0xf, false)); }
__device__ __forceinline__ bool seq_first(int row) { return row < NLAT ? ((row & (SEQ - 1)) == 0) : (((row - NLAT) & (CTXL - 1)) == 0); }
struct EpiUpConv {
    static constexpr bool PERM = true, AFTER_DRAIN = false, AREMAP = true;
    bf16_t* A; const float* cw; int M;
    __device__ __forceinline__ void operator()(const f32x4 (&acc)[2][2][4][2], const pg8::Unit& u, int wr, int wc, int fr_, int fq_) const {
        int fr = fr_, fq = fq_; asm volatile("" : "+v"(fr), "+v"(fq));
        const int lane = fq * 16 + fr;
        const int srcp = (lane & 48) | ((fr + 15) & 15), srcn = (lane & 48) | ((fr + 1) & 15);
        const int chb = u.pn * 128 + wc * 32 + 8 * fq;
#pragma unroll
        for (int n = 0; n < 2; ++n) {
            const int ch = chb + 4 * n;
            f32x4 wvs[4], wgs[4];
#pragma unroll
            for (int e = 0; e < 4; ++e) { wvs[e] = *(const f32x4*)(cw + (size_t)(ch + e) * 8); wgs[e] = *(const f32x4*)(cw + (size_t)(ch + e) * 8 + 4); }
#pragma unroll
            for (int ai = 0; ai < 2; ++ai) {
                const int rowbase = u.pm * 248 + 62 * (2 * ai + wr) - 1;
                float ov[4][4]; int sp_ = srcp, sn_ = srcn;
#pragma unroll
                for (int e = 0; e < 4; ++e) {
                    const f32x4 wva = wvs[e], wga = wgs[e];
                    const float wv0 = wva[0], wv1 = wva[1], wv2 = wva[2], bv = wva[3], wg0 = wga[0], wg1 = wga[1], wg2 = wga[2], bg = wga[3];
#pragma unroll
                    for (int m = 0; m < 4; ++m) {
                        const int t = rowbase + 16 * m + fr;
                        const float cv = acc[ai][0][m][n][e], cg = acc[ai][1][m][n][e];
                        const float cvm = m > 0 ? acc[ai][0][m > 0 ? m - 1 : 0][n][e] : 0.f, cgm = m > 0 ? acc[ai][1][m > 0 ? m - 1 : 0][n][e] : 0.f;
                        const float cvp = m < 3 ? acc[ai][0][m < 3 ? m + 1 : 3][n][e] : 0.f, cgp = m < 3 ? acc[ai][1][m < 3 ? m + 1 : 3][n][e] : 0.f;
                        float pv = dpp_ror1(fr == 15 ? cvm : cv), pg = dpp_ror1(fr == 15 ? cgm : cg);
                        float nv = dpp_ror15(fr == 0 ? cvp : cv), ng = dpp_ror15(fr == 0 ? cgp : cg);
                        if (seq_first(t)) { pv = 0.f; pg = 0.f; }
                        if (seq_first(t + 1)) { nv = 0.f; ng = 0.f; }
                        const float val = wv0 * pv + wv1 * cv + wv2 * nv + bv;
                        const float gat = wg0 * pg + wg1 * cg + wg2 * ng + bg;
                        ov[m][e] = silu_f(gat) * val;
                        __builtin_amdgcn_sched_barrier(0);
                    }
                    if (e == 3) asm volatile("" : "+v"(ov[0][0]), "+v"(ov[1][0]), "+v"(ov[2][0]), "+v"(ov[3][0]), "+v"(ov[0][1]), "+v"(ov[1][1]), "+v"(ov[2][1]), "+v"(ov[3][1]), "+v"(ov[0][2]), "+v"(ov[1][2]), "+v"(ov[2][2]), "+v"(ov[3][2]), "+v"(ov[0][3]), "+v"(ov[1][3]), "+v"(ov[2][3]), "+v"(ov[3][3]), "+v"(sp_), "+v"(sn_));
                }
#pragma unroll
                for (int m = 0; m < 4; ++m) {
                    const int rho = 16 * m + fr, t = rowbase + rho;
                    if (rho >= 1 && rho <= 62 && t < M) { u32x2 w; w.x = cvt_pk_bf16(ov[m][0], ov[m][1]); w.y = cvt_pk_bf16(ov[m][2], ov[m][3]); *(u32x2*)(A + (size_t)t * DFF + ch) = w; }
                }
            }
        }
    }
};
#define XB_TMO      128
#define XB_XCNT(j)  (256  + 64 * (j))
#define XB_XSUB(j)  (1280 + 64 * (j))
#define XB_XGEN(j)  (2304 + 64 * (j))
#define XB_TOP      3328
#define XB_TOPGEN   3392
#define XCD_BAR_WORDS 3456
#define XB_SPIN_CAP (1u << 18)

__device__ __forceinline__ unsigned xb_ld(unsigned* p)              { return __hip_atomic_load(p, __ATOMIC_RELAXED, __HIP_MEMORY_SCOPE_AGENT); }
__device__ __forceinline__ unsigned xb_add(unsigned* p, unsigned v) { return __hip_atomic_fetch_add(p, v, __ATOMIC_RELAXED, __HIP_MEMORY_SCOPE_AGENT); }
__device__ __forceinline__ unsigned xb_xcc_id() { return (unsigned)__builtin_amdgcn_s_getreg((3 << 11) | 20) & 0xFu; }
#define XB_SPIN(cond, bar) do { unsigned _sp = 0; while (cond) { __builtin_amdgcn_s_sleep(1); \
    if ((++_sp & 255u) == 0u) { if (xb_ld(&(bar)[XB_TMO])) break; if (_sp > XB_SPIN_CAP) { atomicAdd(&(bar)[XB_TMO], 1u); break; } } } } while (0)

struct XcdBarrier {
    unsigned* bar; unsigned x;
    volatile LAS unsigned* st;
};

__device__ __forceinline__ XcdBarrier xcd_barrier_post(unsigned* bar, volatile LAS unsigned* st) {
    XcdBarrier b; b.bar = bar; b.x = xb_xcc_id(); b.st = st;
    if (threadIdx.x == 0) (void)xb_add(&bar[XB_XCNT(b.x)], 1u);
    return b;
}
__device__ __forceinline__ void xcd_barrier_complete(unsigned* bar, unsigned x, unsigned& nloc, unsigned& nx) {
    const unsigned G = gridDim.x * gridDim.y * gridDim.z;
    unsigned sum, cnt, mine, sp = 0u;
    for (;;) {
        sum = 0u; cnt = 0u; mine = 0u;
#pragma unroll
        for (unsigned j = 0; j < 16; ++j) { const unsigned c = xb_ld(&bar[XB_XCNT(j)]); sum += c; cnt += (c > 0u) ? 1u : 0u; mine = (j == x) ? c : mine; }
        if (sum == G) break;
        __builtin_amdgcn_s_sleep(1);
        if ((++sp & 255u) == 0u) { if (xb_ld(&bar[XB_TMO])) break; if (sp > XB_SPIN_CAP) { atomicAdd(&bar[XB_TMO], 1u); break; } }
    }
    nloc = mine > 0u ? mine : 1u; nx = cnt > 0u ? cnt : 1u;
}

__device__ __forceinline__ void xcd_barrier(const XcdBarrier& b) {
    asm volatile("s_waitcnt vmcnt(0)" ::: "memory");
    __syncthreads();
    if (threadIdx.x == 0) {
        unsigned* bar = b.bar;
        __builtin_amdgcn_s_waitcnt(0);
        unsigned nloc = b.st[0], nx = b.st[1];
        if (nloc == 0u) { xcd_barrier_complete(bar, b.x, nloc, nx); b.st[0] = nloc; b.st[1] = nx; }
        const unsigned old = xb_add(&bar[XB_XSUB(b.x)], 1u);
        const unsigned gen = old / nloc;
        if (old + 1u == (gen + 1u) * nloc) {
            __builtin_amdgcn_fence(__ATOMIC_RELEASE, "agent");
            asm volatile("s_waitcnt vmcnt(0)" ::: "memory");
            const unsigned og = xb_add(&bar[XB_TOP], 1u);
            const unsigned tg = og / nx;
            if (og + 1u == (tg + 1u) * nx) xb_add(&bar[XB_TOPGEN], 1u);
            else XB_SPIN(xb_ld(&bar[XB_TOPGEN]) == tg, bar);
            __builtin_amdgcn_fence(__ATOMIC_ACQUIRE, "agent");
            xb_add(&bar[XB_XGEN(b.x)], 1u);
            asm volatile("s_waitcnt vmcnt(0)" ::: "memory");
        } else {
            XB_SPIN(xb_ld(&bar[XB_XGEN(b.x)]) == gen, bar);
            __builtin_amdgcn_fence(__ATOMIC_ACQUIRE, "agent");
            asm volatile("s_waitcnt vmcnt(0)" ::: "memory");
        }
    }
    __syncthreads();
}
__device__ __forceinline__ int src_in(int r) {
    if (r < PW) {
        int d, s, hd;
        if (r < 256) { d = 0; s = 0; hd = 64; }
        else if (r < 384) { d = 256; s = 256; hd = 64; }
        else if (r < 896) { d = 384; s = 512; hd = 64; }
        else if (r < 1408) { d = 896; s = 1024; hd = 64; }
        else if (r < 1536) { d = 1408; s = 2048; hd = 32; }
        else if (r < 1664) { d = 1536; s = 2176; hd = 32; }
        else { d = 1664; s = 2560; hd = 0; }
        int jl = r - d;
        if (hd) { const int head = jl / hd, p = jl % hd; jl = head * hd + (p & 1) * (hd / 2) + (p >> 1); }
        return s + jl;
    }
    const int q = r - PW;
    if (q < 128) return 384 + q;
    if (q < 640) return 1536 + (q - 128);
    if (q < 896) return 2304 + (q - 640);
    return 2560 + 128 + (q - 896);
}
__device__ __forceinline__ void transpose_item(const float* W, int K, int N, bf16_t* WT, int inmap, volatile LAS float* scr, int item, int nblk, int lane) {
    const int kb = item / nblk, nb = item % nblk, k0 = 64 * kb, n0 = 32 * nb;
    const int nn = n0 + (lane & 31); const int sc = inmap == 1 ? src_in(nn) : (inmap == 2 ? (((nn & 255) < 128) ? 128 * (nn >> 8) + (nn & 255) : DFF + 128 * (nn >> 8) + (nn & 255) - 128) : nn);
#pragma unroll 8
    for (int i = 0; i < 32; ++i) { const int kk = 2 * i + (lane >> 5); scr[kk * 33 + (lane & 31)] = sc >= 0 ? W[(size_t)(k0 + kk) * N + sc] : 0.f; }
    const int c = lane & 7;
#pragma unroll
    for (int j = 0; j < 4; ++j) { const int n = (lane >> 3) + 8 * j; volatile LAS float* s = scr + (8 * c) * 33 + n;
        u32x4 o; o.x = cvt_pk_bf16(s[0 * 33], s[1 * 33]); o.y = cvt_pk_bf16(s[2 * 33], s[3 * 33]); o.z = cvt_pk_bf16(s[4 * 33], s[5 * 33]); o.w = cvt_pk_bf16(s[6 * 33], s[7 * 33]);
        *(u32x4*)(WT + (size_t)(n0 + n) * K + k0 + 8 * c) = o; }
}
__device__ __forceinline__ float inv_freq(int j, int nf) {
    const int jj = (nf == 16) ? j : 2 * j;
    const int q = jj >> 2, r = jj & 3;
    const float b = r == 0 ? 1.0f : (r == 1 ? 0.5623413251903491f : (r == 2 ? 0.31622776601683794f : 0.17782794100389228f));
    const float p = q == 0 ? 1.0f : (q == 1 ? 0.1f : (q == 2 ? 0.01f : 0.001f));
    return b * p;
}
__device__ __forceinline__ void prep_phase(KArgs a, ldsp lds, int G) {
    const int tid = ltid(), lane = tid & 63, wid = tid >> 6, bid = lbid();
    unsigned char* ws = a->ws;
    float* modv = (float*)(ws + WS_MOD);
    {
        volatile LAS float* sl = (volatile LAS float*)(lds);
        volatile LAS float* red = (volatile LAS float*)(lds + 5 * 1024 * 4);
        for (int i = tid; i < 5 * DM; i += 512) sl[i] = silu_f(i < 4 * DM ? a->in[I_C][i] : a->in[I_CCTX][i - 4 * DM]);
        __syncthreads();
        const int kc = tid >> 5, j = tid & 31;
        for (int item = bid; item < 2 * 192; item += G) {
            const int l = item / 192, nb = item % 192, n = nb * 32 + j;
            float acc[5] = {0.f, 0.f, 0.f, 0.f, 0.f};
            const float* wm = a->in[I_WMOD] + ((size_t)l * DM + kc * 64) * NMOD + n;
#pragma unroll 8
            for (int kk = 0; kk < 64; ++kk) {
                const float w = wm[(size_t)kk * NMOD];
#pragma unroll
                for (int mi = 0; mi < 5; ++mi) acc[mi] += sl[mi * DM + kc * 64 + kk] * w;
            }
#pragma unroll
            for (int mi = 0; mi < 5; ++mi) red[(kc * 5 + mi) * 32 + j] = acc[mi];
            __syncthreads();
            if (tid < 160) {
                const int mi = tid >> 5;
                float s = a->in[I_BMOD][l * NMOD + n];
#pragma unroll
                for (int q = 0; q < 16; ++q) s += red[(q * 5 + mi) * 32 + j];
                modv[(size_t)(l * 5 + mi) * NMOD + n] = s;
            }
            __syncthreads();
        }
    }
    if (bid == 0) {
        float* scal = (float*)(ws + WS_SCAL);
        if (tid < 2) {
            const float* dl = a->in[I_DLAM] + tid * 256;
            float s1 = 0.f, s2 = 0.f;
            for (int i = 0; i < 64; ++i) { s1 += dl[i] * dl[64 + i]; s2 += dl[128 + i] * dl[192 + i]; }
            const float lam_init = 0.8f - 0.6f * expf(-0.3f * (float)tid);
            scal[tid] = expf(s1) - expf(s2) + lam_init;
            scal[2 + tid] = lam_init;
        } else if (tid >= 64 && tid < 80) {
            const int i = tid - 64;
            const float x = a->in[I_RDL][i];
            scal[8 + i] = -log1pf(expf(-x)) * LOG2E;
        }
    }
    {
        float* cwp = (float*)(ws + WS_CWP);
        for (int i = bid * 512 + tid; i < 2 * DFF; i += G * 512) {
            const int l = i / DFF, ch = i % DFF;
            const float* w = a->in[I_CONVW] + (size_t)l * 3 * NUP; const float* b = a->in[I_CONVB] + (size_t)l * NUP;
            f32x4 va = {w[ch], w[NUP + ch], w[2 * NUP + ch], b[ch]}, ga = {w[DFF + ch], w[NUP + DFF + ch], w[2 * NUP + DFF + ch], b[DFF + ch]};
            *(f32x4*)(cwp + (size_t)i * 8) = va; *(f32x4*)(cwp + (size_t)i * 8 + 4) = ga;
        }
    }
    {
        float* c64 = (float*)(ws + WS_ROPE); float* s64 = c64 + SEQ * 32; float* c32 = s64 + SEQ * 32; float* s32 = c32 + SEQ * 16;
        for (int e = bid * 512 + tid; e < SEQ * 48; e += G * 512) {
            const int t = e / 48, i = e % 48;
            float ang;
            if (i < 32) { const float pos = (float)((i < 16) ? (t >> 6) : (t & 63)); ang = pos * inv_freq(i & 15, 16); }
            else { const int ii = i - 32; const float pos = (float)((ii < 8) ? (t >> 6) : (t & 63)); ang = pos * inv_freq(ii & 7, 8); }
            double rv = (double)ang * 0.15915494309189535; rv -= rint(rv);
            const float rr = (float)rv;
            const float sn = __builtin_amdgcn_sinf(rr), cs = __builtin_amdgcn_cosf(rr);
            if (i < 32) { c64[t * 32 + i] = cs; s64[t * 32 + i] = sn; } else { c32[t * 16 + i - 32] = cs; s32[t * 16 + i - 32] = sn; }
        }
    }
    {
        volatile LAS float* scr = (volatile LAS float*)(lds + wid * 16384);
        const int gw = bid * 8 + wid, NGW = G * 8;
        constexpr int I_IN = 16 * 88, I_OUT = 16 * 32, I_UP = 16 * 176, I_DN = 44 * 32, I_L = I_IN + I_OUT + I_UP + I_DN;
        for (int it = gw; it < 2 * I_L; it += NGW) {
            const int l = it / I_L; int r = it % I_L;
            if (r < I_IN) { transpose_item(a->in[I_WIN] + (size_t)l * DM * INW, DM, INW, (bf16_t*)(ws + WS_WIN) + (size_t)l * 3072 * DM, 1, scr, r, 88, lane); continue; } r -= I_IN;
            if (r < I_OUT) { transpose_item(a->in[I_WOUT] + (size_t)l * DM * DM, DM, DM, (bf16_t*)(ws + WS_WOUT) + (size_t)l * DM * DM, 0, scr, r, 32, lane); continue; } r -= I_OUT;
            if (r < I_UP) { transpose_item(a->in[I_WUP] + (size_t)l * DM * NUP, DM, NUP, (bf16_t*)(ws + WS_WUP) + (size_t)l * NUP * DM, 2, scr, r, 176, lane); continue; } r -= I_UP;
            transpose_item(a->in[I_WDN] + (size_t)l * DFF * DM, DFF, DM, (bf16_t*)(ws + WS_WDN) + (size_t)l * DM * DFF, 0, scr, r, 32, lane);
        }
    }
}
constexpr int NRW = 4;
__device__ __forceinline__ void norm_phase(const float* xl, const float* xc, const bf16_t* Xb, const float* g, const float* modl, int shi, int sci, bf16_t* H, int M, int G) {
    const int tid = ltid(), lane = tid & 63, wid = tid >> 6;
    const int gw = lbid() * 8 + wid, NGW = G * 8;
    for (int row0 = gw; row0 < M; row0 += NRW * NGW) {
        f32x4 v[NRW][4]; float ss[NRW];
#pragma unroll
        for (int q = 0; q < NRW; ++q) {
            const int row = row0 + q * NGW;
            if (row < M) {
                if (xl) {
                    const float* xr = row < NLAT ? xl + (size_t)row * DM : xc + (size_t)(row - NLAT) * DM;
#pragma unroll
                    for (int j = 0; j < 2; ++j) { v[q][2 * j] = *(const f32x4*)(xr + 512 * j + 8 * lane); v[q][2 * j + 1] = *(const f32x4*)(xr + 512 * j + 8 * lane + 4); }
                } else {
#pragma unroll
                    for (int j = 0; j < 2; ++j) { const u32x4 w = *(const u32x4*)(Xb + (size_t)row * DM + 512 * j + 8 * lane);
                        v[q][2 * j] = (f32x4){bflo(w.x), bfhi(w.x), bflo(w.y), bfhi(w.y)}; v[q][2 * j + 1] = (f32x4){bflo(w.z), bfhi(w.z), bflo(w.w), bfhi(w.w)}; }
                }
            } else {
#pragma unroll
                for (int j = 0; j < 4; ++j) v[q][j] = (f32x4){0.f, 0.f, 0.f, 0.f};
            }
        }
#pragma unroll
        for (int q = 0; q < NRW; ++q) { float s = 0.f;
#pragma unroll
            for (int j = 0; j < 4; ++j) s += (v[q][j][0] * v[q][j][0] + v[q][j][1] * v[q][j][1]) + (v[q][j][2] * v[q][j][2] + v[q][j][3] * v[q][j][3]);
            ss[q] = s; }
#pragma unroll
        for (int o = 1; o < 64; o <<= 1) {
#pragma unroll
            for (int q = 0; q < NRW; ++q) ss[q] += __shfl_xor(ss[q], o);
        }
#pragma unroll
        for (int q = 0; q < NRW; ++q) {
            const int row = row0 + q * NGW;
            if (row < M) {
                const int mi = mod_index(row);
                const float rstd = rsqrtf(ss[q] * (1.f / DM) + EPS);
#pragma unroll
                for (int j = 0; j < 2; ++j) {
                    u32x4 o;
#pragma unroll
                    for (int h = 0; h < 2; ++h) {
                        const int col = 512 * j + 8 * lane + 4 * h;
                        const f32x4 gg = *(const f32x4*)(g + col);
                        const f32x4 sc = *(const f32x4*)(modl + (size_t)mi * NMOD + sci * DM + col);
                        const f32x4 sh = *(const f32x4*)(modl + (size_t)mi * NMOD + shi * DM + col);
                        const f32x4 y = (v[q][2 * j + h] * rstd) * gg * (sc + 1.0f) + sh;
                        if (h == 0) { o.x = cvt_pk_bf16(y[0], y[1]); o.y = cvt_pk_bf16(y[2], y[3]); } else { o.z = cvt_pk_bf16(y[0], y[1]); o.w = cvt_pk_bf16(y[2], y[3]); }
                    }
                    *(u32x4*)(H + (size_t)row * DM + 512 * j + 8 * lane) = o;
                }
            }
        }
    }
}
__device__ __forceinline__ void final_norm_phase(const bf16_t* Xb, float* out, const float* g, int G) {
    const int tid = ltid(), lane = tid & 63, wid = tid >> 6;
    const int gw = lbid() * 8 + wid, NGW = G * 8;
    f32x4 gq[4];
#pragma unroll
    for (int j = 0; j < 4; ++j) gq[j] = *(const f32x4*)(g + 512 * (j >> 1) + 8 * lane + 4 * (j & 1));
    for (int row0 = gw; row0 < NLAT; row0 += NRW * NGW) {
        f32x4 v[NRW][4]; float ss[NRW];
#pragma unroll
        for (int q = 0; q < NRW; ++q) {
            const int row = row0 + q * NGW;
#pragma unroll
            for (int j = 0; j < 2; ++j) {
                u32x4 w = {0u, 0u, 0u, 0u};
                if (row < NLAT) w = *(const u32x4*)(Xb + (size_t)row * DM + 512 * j + 8 * lane);
                v[q][2 * j] = (f32x4){bflo(w.x), bfhi(w.x), bflo(w.y), bfhi(w.y)}; v[q][2 * j + 1] = (f32x4){bflo(w.z), bfhi(w.z), bflo(w.w), bfhi(w.w)};
            }
        }
#pragma unroll
        for (int q = 0; q < NRW; ++q) { float s = 0.f;
#pragma unroll
            for (int j = 0; j < 4; ++j) s += (v[q][j][0] * v[q][j][0] + v[q][j][1] * v[q][j][1]) + (v[q][j][2] * v[q][j][2] + v[q][j][3] * v[q][j][3]);
            ss[q] = s; }
#pragma unroll
        for (int o = 1; o < 64; o <<= 1) {
#pragma unroll
            for (int q = 0; q < NRW; ++q) ss[q] += __shfl_xor(ss[q], o);
        }
#pragma unroll
        for (int q = 0; q < NRW; ++q) {
            const int row = row0 + q * NGW;
            if (row < NLAT) {
                const float rstd = rsqrtf(ss[q] * (1.f / DM) + EPS);
#pragma unroll
                for (int j = 0; j < 4; ++j) { const int col = 512 * (j >> 1) + 8 * lane + 4 * (j & 1); *(f32x4*)(out + (size_t)row * DM + col) = (v[q][j] * rstd) * gq[j]; }
            }
        }
    }
}
__device__ __forceinline__ float max3f(float a, float b, float c) { float r; asm("v_max3_f32 %0, %1, %2, %3" : "=v"(r) : "v"(a), "v"(b), "v"(c)); return r; }
#define MFMA32(a, b, c) __builtin_amdgcn_mfma_f32_32x32x16_bf16((a), (b), (c), 0, 0, 0)
struct AttnSeg { const bf16_t* Kc; const bf16_t* Kl; const bf16_t* Vc; const bf16_t* Vl; int nctx, t0, t1; };
constexpr int ATT_KB = 64 * 144;
constexpr int ATT_VS = 144;
constexpr int ATT_VB = 128 * ATT_VS;
constexpr int ATT_VOFF = 2 * ATT_KB;
constexpr int ATT_WSF = ATT_VOFF + 3 * ATT_VB;

template <int DV, bool WIN>
__device__ __forceinline__ void attn_pass(ldsp lds, const AttnSeg& S, const bf16x8 (&qr)[4], int qpos, f32x16 (&o)[DV / 32], float& m, float& l) {
    const int tid = ltid(), lane = tid & 63, r32 = lane & 31, hi = lane >> 5, wid = __builtin_amdgcn_readfirstlane(tid >> 6);
    constexpr int NV = DV / 64, ND = DV / 32;
    constexpr int EPG = (DV == 128) ? 2 : 4;
    volatile LAS float* wsf = (volatile LAS float*)(lds + ATT_WSF) + wid * 64;
    const int NT = S.nctx + (S.t1 - S.t0);
    const int krow = tid >> 3, kch = tid & 7;
    u32x4 sk; u32x4 sv[NV];
#define SB() __builtin_amdgcn_sched_barrier(0)
#define ATT_LOAD(i) do { const int _i = (i); const bf16_t* kp; const bf16_t* vp; \
        if (_i < S.nctx) { kp = S.Kc + (size_t)_i * 64 * PW; vp = S.Vc + _i * 64; } else { const int _t = S.t0 + _i - S.nctx; kp = S.Kl + (size_t)_t * 64 * PW; vp = S.Vl + _t * 64; } \
        sk = *(const u32x4*)(kp + (size_t)krow * PW + kch * 8); \
        _Pragma("unroll") for (int j = 0; j < NV; ++j) { const int idx = tid + 512 * j; sv[j] = *(const u32x4*)(vp + (size_t)(idx >> 3) * MTOT + (idx & 7) * 8); } } while (0)
#define ATT_STORE(kbuf, vbuf) do { *(LAS u32x4*)(lds + (kbuf) * ATT_KB + krow * 144 + kch * 16) = sk; \
        _Pragma("unroll") for (int j = 0; j < NV; ++j) { const int idx = tid + 512 * j; const int c_ = idx & 7; ldsp vq = lds + ATT_VOFF + (vbuf) * ATT_VB + (idx >> 3) * ATT_VS + (c_ >> 1) * 32 + (c_ & 1) * 8; \
            *(LAS u32x2*)(vq) = (u32x2){sv[j].x, sv[j].y}; *(LAS u32x2*)(vq + 16) = (u32x2){sv[j].z, sv[j].w}; } } while (0)
#define ATT_VLOAD(dst, Vb_, dblk) do { _Pragma("unroll") for (int j = 0; j < 4; ++j) dst[j] = *(const LAS bf16x8*)((Vb_) + (32 * (dblk) + r32) * ATT_VS + (16 * j + 8 * hi) * 2); } while (0)
#define ATT_KLOAD(Kb_) do { _Pragma("unroll") for (int d0 = 0; d0 < 4; ++d0) { kf[2 * d0] = *(const LAS bf16x8*)((Kb_) + r32 * 144 + (d0 * 16 + hi * 8) * 2); \
            kf[2 * d0 + 1] = *(const LAS bf16x8*)((Kb_) + (32 + r32) * 144 + (d0 * 16 + hi * 8) * 2); } } while (0)
#define EL(X0, X1, e) ((e) < 16 ? X0[(e) & 15] : X1[(e) & 15])
#define ATT_QK(C0, C1, P0, P1, Kb_, PREV) do { bf16x8 kf[8]; ATT_KLOAD(Kb_); SB(); float sacc = 0.f; \
        _Pragma("unroll") for (int q = 0; q < 8; ++q) { \
            if (q == 0) C0 = MFMA32(kf[0], qr[0], zero16); else if (q == 1) C1 = MFMA32(kf[1], qr[0], zero16); \
            else if ((q & 1) == 0) C0 = MFMA32(kf[q], qr[q >> 1], C0); else C1 = MFMA32(kf[q], qr[q >> 1], C1); \
            if (PREV) { sacc += EL(P0, P1, 4 * q) + EL(P0, P1, 4 * q + 1); sacc += EL(P0, P1, 4 * q + 2) + EL(P0, P1, 4 * q + 3); \
                pw[2 * q] = cvt_pk_bf16(EL(P0, P1, 4 * q), EL(P0, P1, 4 * q + 1)); pw[2 * q + 1] = cvt_pk_bf16(EL(P0, P1, 4 * q + 2), EL(P0, P1, 4 * q + 3)); } \
            SB(); } \
        if (PREV) l += sacc; } while (0)
#define PAF(j) __builtin_bit_cast(bf16x8, (u32x4){pw[4 * (j)], pw[4 * (j) + 1], pw[4 * (j) + 2], pw[4 * (j) + 3]})
#define ATT_MAX(C0, C1, I) do { \
        if (WIN && (I) >= S.nctx) { const int kp0 = (S.t0 + (I) - S.nctx) * 64 - qpos; \
            _Pragma("unroll") for (int r = 0; r < 16; ++r) { const int dlt = kp0 + crow(r, hi); if (dlt > 128 || dlt < -128) C0[r] = -1e30f; if (dlt + 32 > 128 || dlt + 32 < -128) C1[r] = -1e30f; } } \
        asm volatile("s_nop 15\n\ts_nop 7" : "+v"(C0), "+v"(C1)); \
        float mx = max3f(C0[0], C0[1], C1[0]), mx2 = max3f(C0[2], C0[3], C1[1]); mx = max3f(mx, C1[2], C1[3]); \
        _Pragma("unroll") for (int r = 4; r < 16; r += 4) { mx = max3f(mx, C0[r], C0[r + 1]); mx2 = max3f(mx2, C0[r + 2], C0[r + 3]); mx = max3f(mx, C1[r], C1[r + 1]); mx2 = max3f(mx2, C1[r + 2], C1[r + 3]); } \
        mx = fmaxf(mx, mx2); mx = fmaxf(mx, __shfl_xor(mx, 32)); \
        mnew = (mx > m + 8.0f) ? mx : m; alpha = __builtin_amdgcn_exp2f(m - mnew); } while (0)
#define ATT_EXP(C0, C1, e) do { if ((e) < 16) C0[(e) & 15] = __builtin_amdgcn_exp2f(C0[(e) & 15] - mnew); else C1[(e) & 15] = __builtin_amdgcn_exp2f(C1[(e) & 15] - mnew); } while (0)
#define ATT_PVX(C0, C1, Vb_, DOEXP) do { bf16x8 va[4], vb[4]; ATT_VLOAD(va, Vb_, 0); ATT_VLOAD(vb, Vb_, 1); SB(); \
        _Pragma("unroll") for (int j = 0; j < 4; ++j) { o[0] = MFMA32(PAF(j), va[j], o[0]); if (DOEXP) { _Pragma("unroll") for (int x = 0; x < EPG; ++x) ATT_EXP(C0, C1, EPG * j + x); asm volatile("" : "+v"(C0), "+v"(C1)); } SB(); } \
        if constexpr (DV == 128) { ATT_VLOAD(va, Vb_, 2); SB(); } \
        _Pragma("unroll") for (int j = 0; j < 4; ++j) { o[1] = MFMA32(PAF(j), vb[j], o[1]); if (DOEXP) { _Pragma("unroll") for (int x = 0; x < EPG; ++x) ATT_EXP(C0, C1, EPG * (4 + j) + x); asm volatile("" : "+v"(C0), "+v"(C1)); } SB(); } \
        if constexpr (DV == 128) { ATT_VLOAD(vb, Vb_, 3); SB(); \
            _Pragma("unroll") for (int j = 0; j < 4; ++j) { o[2] = MFMA32(PAF(j), va[j], o[2]); if (DOEXP) { _Pragma("unroll") for (int x = 0; x < EPG; ++x) ATT_EXP(C0, C1, EPG * (8 + j) + x); asm volatile("" : "+v"(C0), "+v"(C1)); } SB(); } \
            _Pragma("unroll") for (int j = 0; j < 4; ++j) { o[3] = MFMA32(PAF(j), vb[j], o[3]); if (DOEXP) { _Pragma("unroll") for (int x = 0; x < EPG; ++x) ATT_EXP(C0, C1, EPG * (12 + j) + x); asm volatile("" : "+v"(C0), "+v"(C1)); } SB(); } } } while (0)
#define ATT_RESCALE() do { if (__any(alpha != 1.0f)) { if (hi == 0) wsf[r32] = alpha; \
            _Pragma("unroll") for (int r = 0; r < 16; ++r) { const float a_ = wsf[crow(r, hi)]; _Pragma("unroll") for (int d = 0; d < ND; ++d) o[d][r] *= a_; } \
            l *= alpha; } m = mnew; } while (0)
#define ATT_TAIL(I) do { if (more) ATT_STORE(((I) + 1) & 1, vnext); __syncthreads(); vprev = vcur; vcur = vnext; vnext = (vnext == 2) ? 0 : vnext + 1; } while (0)
#define ATT_ITER(C0, C1, P0, P1, I) do { const bool more = ((I) + 1) < NT; if (more) ATT_LOAD((I) + 1); \
        ldsp Kb_ = lds + ((I) & 1) * ATT_KB; ldsp Vp_ = lds + ATT_VOFF + vprev * ATT_VB; \
        ATT_QK(C0, C1, P0, P1, Kb_, true); \
        ATT_MAX(C0, C1, I); SB(); \
        ATT_PVX(C0, C1, Vp_, true); \
        ATT_RESCALE(); ATT_TAIL(I); } while (0)
    f32x16 zero16;
#pragma unroll
    for (int r = 0; r < 16; ++r) zero16[r] = 0.f;
    f32x16 pA0, pA1, pB0, pB1;
    unsigned pw[16];
    float mnew, alpha;
    int vprev = 2, vcur = 0, vnext = 1;
    ATT_LOAD(0); ATT_STORE(0, 0);
    __syncthreads();
    {
        const bool more = 1 < NT; if (more) ATT_LOAD(1);
        ldsp Kb_ = lds;
        ATT_QK(pA0, pA1, pB0, pB1, Kb_, false);
        ATT_MAX(pA0, pA1, 0);
#pragma unroll
        for (int e = 0; e < 32; ++e) ATT_EXP(pA0, pA1, e);
        ATT_RESCALE(); ATT_TAIL(0);
    }
    int i = 1;
    for (; i + 1 < NT; i += 2) { ATT_ITER(pB0, pB1, pA0, pA1, i); ATT_ITER(pA0, pA1, pB0, pB1, i + 1); }
    if (i < NT) {
        ATT_ITER(pB0, pB1, pA0, pA1, i);
        float sacc = 0.f;
#pragma unroll
        for (int q = 0; q < 8; ++q) { sacc += EL(pB0, pB1, 4 * q) + EL(pB0, pB1, 4 * q + 1); sacc += EL(pB0, pB1, 4 * q + 2) + EL(pB0, pB1, 4 * q + 3);
            pw[2 * q] = cvt_pk_bf16(EL(pB0, pB1, 4 * q), EL(pB0, pB1, 4 * q + 1)); pw[2 * q + 1] = cvt_pk_bf16(EL(pB0, pB1, 4 * q + 2), EL(pB0, pB1, 4 * q + 3)); }
        l += sacc;
    } else {
        float sacc = 0.f;
#pragma unroll
        for (int q = 0; q < 8; ++q) { sacc += EL(pA0, pA1, 4 * q) + EL(pA0, pA1, 4 * q + 1); sacc += EL(pA0, pA1, 4 * q + 2) + EL(pA0, pA1, 4 * q + 3);
            pw[2 * q] = cvt_pk_bf16(EL(pA0, pA1, 4 * q), EL(pA0, pA1, 4 * q + 1)); pw[2 * q + 1] = cvt_pk_bf16(EL(pA0, pA1, 4 * q + 2), EL(pA0, pA1, 4 * q + 3)); }
        l += sacc;
    }
    { ldsp Vp_ = lds + ATT_VOFF + vprev * ATT_VB; SB(); ATT_PVX(pA0, pA1, Vp_, false); }
    __syncthreads();
#undef SB
#undef ATT_LOAD
#undef ATT_STORE
#undef ATT_VLOAD
#undef ATT_KLOAD
#undef EL
#undef ATT_QK
#undef PAF
#undef ATT_MAX
#undef ATT_EXP
#undef ATT_PVX
#undef ATT_RESCALE
#undef ATT_TAIL
#undef ATT_ITER
}
template <int ND>
__device__ __forceinline__ void attn_normalize(ldsp lds, f32x16 (&o)[ND], float l) {
    const int tid = ltid(), lane = tid & 63, r32 = lane & 31, hi = lane >> 5, wid = tid >> 6;
    volatile LAS float* wsf = (volatile LAS float*)(lds + ATT_WSF) + wid * 64;
    const float lt = l + __shfl_xor(l, 32);
    if (hi == 0) wsf[r32] = 1.0f / lt;
#pragma unroll
    for (int r = 0; r < 16; ++r) { const float a = wsf[crow(r, hi)];
#pragma unroll
        for (int d = 0; d < ND; ++d) o[d][r] *= a; }
}
__device__ __forceinline__ void load_q(bf16x8 (&qr)[4], const bf16_t* Qp  ) {
    const int lane = ltid() & 63, hi = lane >> 5;
#pragma unroll
    for (int d0 = 0; d0 < 4; ++d0) qr[d0] = *(const bf16x8*)(Qp + d0 * 16 + hi * 8);
}

__device__ __forceinline__ void mixb_unit(ldsp lds, const bf16_t* P, const bf16_t* PT, float* stash, bf16_t* mix, const float* subg, float lam, float lam_init,
                                          int b, int h, int qrow0, bool ctx_only) {
    const int tid = ltid(), lane = tid & 63, r32 = lane & 31, hi = lane >> 5, wid = tid >> 6;
    const int rowq = qrow0 + 32 * wid;
    f32x16 o[4];
#pragma unroll 1
    for (int c = 0; c < 2; ++c) {
        bf16x8 qr[4];
        load_q(qr, P + (size_t)(rowq + r32) * PW + PC_QB + 128 * h + 64 * c);
        AttnSeg S;
        S.Kc = P + (size_t)(NLAT + b * CTXL) * PW + PC_KB + 128 * h + 64 * c;
        S.Kl = P + (size_t)(b * SEQ) * PW + PC_KB + 128 * h + 64 * c;
        S.Vc = PT + (size_t)(PR_VB + 128 * h) * MTOT + NLAT + b * CTXL;
        S.Vl = PT + (size_t)(PR_VB + 128 * h) * MTOT + b * SEQ;
        S.nctx = 4; S.t0 = 0; S.t1 = ctx_only ? 0 : (SEQ / 64);
#pragma unroll
        for (int d = 0; d < 4; ++d)
#pragma unroll
            for (int r = 0; r < 16; ++r) o[d][r] = 0.f;
        float m = -1e30f, l = 0.f;
        attn_pass<128, false>(lds, S, qr, 0, o, m, l);
        attn_normalize<4>(lds, o, l);
        if (c == 0) {
            int rq = rowq * 512 + h * 128 + r32 + 4 * hi * 512; asm volatile("" : "+v"(rq));
            float* sp = stash + rq;
#pragma unroll
            for (int d = 0; d < 4; ++d)
#pragma unroll
                for (int r = 0; r < 16; ++r) sp[((r & 3) + 8 * (r >> 2)) * 512 + 32 * d] = o[d][r];
        }
    }
    float gv[4];
#pragma unroll
    for (int d = 0; d < 4; ++d) gv[d] = subg[32 * d + r32] * (1.0f - lam_init);
    int rq2 = rowq + 4 * hi; asm volatile("" : "+v"(rq2));
    const float* sp2 = stash + (size_t)rq2 * 512 + h * 128 + r32;
    bf16_t* mp2 = mix + (size_t)rq2 * DM + 256 + 128 * h + r32;
    float ss[16];
#pragma unroll
    for (int r = 0; r < 16; ++r) {
        const int ro = (r & 3) + 8 * (r >> 2);
        float s = 0.f;
#pragma unroll
        for (int d = 0; d < 4; ++d) { o[d][r] = sp2[ro * 512 + 32 * d] - lam * o[d][r]; s += o[d][r] * o[d][r]; }
        ss[r] = s;
    }
#pragma unroll
    for (int st = 1; st < 32; st <<= 1) {
#pragma unroll
        for (int r = 0; r < 16; ++r) ss[r] += __shfl_xor(ss[r], st);
    }
#pragma unroll
    for (int r = 0; r < 16; ++r) {
        const int ro = (r & 3) + 8 * (r >> 2);
        const float rstd = rsqrtf(ss[r] * (1.0f / 128.0f) + EPS);
#pragma unroll
        for (int d = 0; d < 4; ++d) { const float y = o[d][r] * rstd * gv[d]; mp2[ro * DM + 32 * d] = (bf16_t)(cvt_pk_bf16(y, 0.f) & 0xffffu); }
    }
}
__device__ __forceinline__ void mixa_unit(ldsp lds, const bf16_t* P, const bf16_t* PT, bf16_t* mix, float sink, int b, int qh, int qrow0, int q0  , bool ctx_only) {
    const int tid = ltid(), lane = tid & 63, r32 = lane & 31, hi = lane >> 5, wid = tid >> 6;
    const int rowq = qrow0 + 32 * wid; const int g = qh >> 1;
    bf16x8 qr[4];
    load_q(qr, P + (size_t)(rowq + r32) * PW + PC_QA + 64 * qh);
    AttnSeg S;
    S.Kc = P + (size_t)(NLAT + b * CTXL) * PW + PC_KA + 64 * g;
    S.Kl = P + (size_t)(b * SEQ) * PW + PC_KA + 64 * g;
    S.Vc = PT + (size_t)(PR_VA + 64 * g) * MTOT + NLAT + b * CTXL;
    S.Vl = PT + (size_t)(PR_VA + 64 * g) * MTOT + b * SEQ;
    S.nctx = 4;
    if (ctx_only) { S.t0 = 0; S.t1 = 0; }
    else { const int lo = q0 - 128, hi_ = q0 + 256 + 128; S.t0 = (lo < 0 ? 0 : lo) / 64; S.t1 = (hi_ > SEQ ? SEQ : hi_) / 64; }
    f32x16 o[2];
#pragma unroll
    for (int d = 0; d < 2; ++d)
#pragma unroll
        for (int r = 0; r < 16; ++r) o[d][r] = 0.f;
    float m = sink * LOG2E, l = (hi == 0) ? 1.0f : 0.0f;
    attn_pass<64, true>(lds, S, qr, q0 + 32 * wid + r32, o, m, l);
    attn_normalize<2>(lds, o, l);
#pragma unroll
    for (int r = 0; r < 16; ++r) { const size_t row = (size_t)(rowq + crow(r, hi));
#pragma unroll
        for (int d = 0; d < 2; ++d) mix[row * DM + 64 * qh + 32 * d + r32] = (bf16_t)(cvt_pk_bf16(o[d][r], 0.f) & 0xffffu); }
}
__device__ __forceinline__ int chunk_row(int b, int cc) { return cc < 2 ? NLAT + b * CTXL + 128 * cc : b * SEQ + 128 * (cc - 2); }
__device__ __forceinline__ void r1_unit(const bf16_t* P, const bf16_t* PT, float* KV, const float* lg, int b, int h, int cc) {
    const int lane = ltid() & 63, r32 = lane & 31, hi = lane >> 5;
    const int tok0 = chunk_row(b, cc);
    const float lgf = lg[h], lgb = lg[4 + h];
    f32x16 of[2], ob[2];
#pragma unroll
    for (int d = 0; d < 2; ++d)
#pragma unroll
        for (int r = 0; r < 16; ++r) { of[d][r] = 0.f; ob[d][r] = 0.f; }
#pragma unroll 4
    for (int kb = 0; kb < 8; ++kb) {
        float kf[8], kk[8];
#pragma unroll
        for (int i = 0; i < 8; ++i) {
            const int key = 16 * kb + 8 * hi + i;
            const float kv = bf2f(P[(size_t)(tok0 + key) * PW + PC_KR + 32 * h + r32]);
            kf[i] = kv * __builtin_amdgcn_exp2f(lgf * (float)(127 - key));
            kk[i] = kv * __builtin_amdgcn_exp2f(lgb * (float)key);
        }
        u32x4 wf, wb;
        wf.x = cvt_pk_bf16(kf[0], kf[1]); wf.y = cvt_pk_bf16(kf[2], kf[3]); wf.z = cvt_pk_bf16(kf[4], kf[5]); wf.w = cvt_pk_bf16(kf[6], kf[7]);
        wb.x = cvt_pk_bf16(kk[0], kk[1]); wb.y = cvt_pk_bf16(kk[2], kk[3]); wb.z = cvt_pk_bf16(kk[4], kk[5]); wb.w = cvt_pk_bf16(kk[6], kk[7]);
        const bf16x8 bfv = __builtin_bit_cast(bf16x8, wf), bbv = __builtin_bit_cast(bf16x8, wb);
#pragma unroll
        for (int d = 0; d < 2; ++d) {
            const bf16x8 av = *(const bf16x8*)(PT + (size_t)(PR_VR + 64 * h + 32 * d + r32) * MTOT + tok0 + 16 * kb + 8 * hi);
            of[d] = MFMA32(av, bfv, of[d]); ob[d] = MFMA32(av, bbv, ob[d]);
        }
    }
    float* kvp = KV + ((size_t)((b * 4 + h) * NCH + cc) * 2) * 2048;
#pragma unroll
    for (int d = 0; d < 2; ++d)
#pragma unroll
        for (int r = 0; r < 16; ++r) { const int idx = (32 * d + crow(r, hi)) * 32 + r32; kvp[idx] = of[d][r]; kvp[2048 + idx] = ob[d][r]; }
}
__device__ __forceinline__ void r2_phase(const float* KV, float* ST, const float* lg, int G) {
    for (int t = lbid() * 512 + ltid(); t < 16 * 2 * 2048; t += G * 512) {
        const int e = t & 2047, dir = (t >> 11) & 1, bh = t >> 12, h = bh & 3;
        const float dc = __builtin_amdgcn_exp2f(lg[dir * 4 + h] * 128.0f);
        const float* kv = KV + (size_t)bh * NCH * 4096 + dir * 2048 + e;
        float* st = ST + (size_t)bh * NCH * 4096 + dir * 2048 + e;
        float s = 0.f;
#pragma unroll 1
        for (int g0 = 0; g0 < NCH; g0 += 33) {
            float kvv[33];
#pragma unroll
            for (int q = 0; q < 33; ++q) {
                const int sidx = g0 + q;
                const int cc = (dir == 0) ? sidx : ((sidx < 2) ? (1 - sidx) : (NCH + 1 - sidx));
                kvv[q] = kv[(size_t)cc * 4096];
            }
#pragma unroll
            for (int q = 0; q < 33; ++q) {
                const int sidx = g0 + q;
                const int cc = (dir == 0) ? sidx : ((sidx < 2) ? (1 - sidx) : (NCH + 1 - sidx));
                st[(size_t)cc * 4096] = s; s = dc * s + kvv[q];
            }
        }
    }
}
__device__ __forceinline__ bf16x8 scale_bf16x8(bf16x8 v, float s) {
    const u32x4 w = __builtin_bit_cast(u32x4, v); u32x4 o;
    o.x = cvt_pk_bf16(bflo(w.x) * s, bfhi(w.x) * s); o.y = cvt_pk_bf16(bflo(w.y) * s, bfhi(w.y) * s);
    o.z = cvt_pk_bf16(bflo(w.z) * s, bfhi(w.z) * s); o.w = cvt_pk_bf16(bflo(w.w) * s, bfhi(w.w) * s);
    return __builtin_bit_cast(bf16x8, o);
}
__device__ __forceinline__ void r3_unit(ldsp lds, const bf16_t* P, const bf16_t* PT, const float* ST, bf16_t* mix, const float* lg, int b, int h, int blk, bool is_ctx) {
    const int tid = ltid(), lane = tid & 63, r32 = lane & 31, hi = lane >> 5, wid = tid >> 6;
    const int cw = 2 * blk + (wid >> 2), cc = is_ctx ? cw : cw + 2, i0 = 32 * (wid & 3);
    const int tok0 = chunk_row(b, cc);
    const float lgf = lg[h], lgb = lg[4 + h];
    constexpr int R3_KS = 80, R3_KC = 128 * R3_KS, R3_VS = 272, R3_VC = 64 * R3_VS, R3_VOFF = 2 * R3_KC;
    {
        const int cc0 = is_ctx ? 2 * blk : 2 * blk + 2;
        u32x4 kreg[2], vreg[4];
#pragma unroll
        for (int j = 0; j < 2; ++j) { const int p = tid + 512 * j, ch = p >> 9, row = (p >> 2) & 127, part = p & 3;
            kreg[j] = *(const u32x4*)(P + (size_t)(chunk_row(b, cc0 + ch) + row) * PW + PC_KR + 32 * h + part * 8); }
#pragma unroll
        for (int j = 0; j < 4; ++j) { const int p = tid + 512 * j, ch = p >> 10, row = (p >> 4) & 63, part = p & 15;
            vreg[j] = *(const u32x4*)(PT + (size_t)(PR_VR + 64 * h + row) * MTOT + chunk_row(b, cc0 + ch) + part * 8); }
#pragma unroll
        for (int j = 0; j < 2; ++j) { const int p = tid + 512 * j, ch = p >> 9, row = (p >> 2) & 127, part = p & 3;
            *(LAS u32x4*)(lds + ch * R3_KC + row * R3_KS + part * 16) = kreg[j]; }
#pragma unroll
        for (int j = 0; j < 4; ++j) { const int p = tid + 512 * j, ch = p >> 10, row = (p >> 4) & 63, part = p & 15;
            *(LAS u32x4*)(lds + R3_VOFF + ch * R3_VC + row * R3_VS + part * 16) = vreg[j]; }
    }
    __syncthreads();
    ldsp Kl = lds + (wid >> 2) * R3_KC; ldsp Vl = lds + R3_VOFF + (wid >> 2) * R3_VC;
    bf16x8 q2[2];
#pragma unroll
    for (int d0 = 0; d0 < 2; ++d0) q2[d0] = *(const bf16x8*)(P + (size_t)(tok0 + i0 + r32) * PW + PC_QR + 32 * h + 16 * d0 + 8 * hi);
    f32x16 o[2];
#pragma unroll
    for (int d = 0; d < 2; ++d)
#pragma unroll
        for (int r = 0; r < 16; ++r) o[d][r] = 0.f;
    const int qi = i0 + r32;
#pragma unroll 1
    for (int kb = 0; kb < 4; ++kb) {
        f32x16 p;
#pragma unroll
        for (int r = 0; r < 16; ++r) p[r] = 0.f;
#pragma unroll
        for (int d0 = 0; d0 < 2; ++d0) {
            const bf16x8 kf = *(const LAS bf16x8*)(Kl + (32 * kb + r32) * R3_KS + (16 * d0 + 8 * hi) * 2);
            p = MFMA32(kf, q2[d0], p);
        }
#pragma unroll
        for (int r = 0; r < 16; ++r) {
            const int dlt = qi - (32 * kb + crow(r, hi));
            const float w = dlt >= 0 ? __builtin_amdgcn_exp2f(lgf * (float)dlt) : __builtin_amdgcn_exp2f(lgb * (float)(-dlt));
            p[r] *= w;
        }
        u32x4 w0, w1;
        w0.x = cvt_pk_bf16(p[0], p[1]); w0.y = cvt_pk_bf16(p[2], p[3]); w0.z = cvt_pk_bf16(p[4], p[5]); w0.w = cvt_pk_bf16(p[6], p[7]);
        w1.x = cvt_pk_bf16(p[8], p[9]); w1.y = cvt_pk_bf16(p[10], p[11]); w1.z = cvt_pk_bf16(p[12], p[13]); w1.w = cvt_pk_bf16(p[14], p[15]);
        const bf16x8 pa0 = __builtin_bit_cast(bf16x8, w0), pa1 = __builtin_bit_cast(bf16x8, w1);
#pragma unroll
        for (int d = 0; d < 2; ++d)
#pragma unroll
            for (int jj = 0; jj < 2; ++jj) {
                ldsp vp = Vl + (32 * d + r32) * R3_VS + (32 * kb + 16 * jj + 4 * hi) * 2;
                const s16x4 lo = *(const LAS s16x4*)(vp), h4 = *(const LAS s16x4*)(vp + 16);
                const bf16x8 vf = (bf16x8){lo[0], lo[1], lo[2], lo[3], h4[0], h4[1], h4[2], h4[3]};
                o[d] = MFMA32(jj == 0 ? pa0 : pa1, vf, o[d]);
            }
    }
#pragma unroll
    for (int dir = 0; dir < 2; ++dir) {
        const float s = dir == 0 ? __builtin_amdgcn_exp2f(lgf * (float)(qi + 1)) : __builtin_amdgcn_exp2f(lgb * (float)(128 - qi));
        const float* stp = ST + ((size_t)((b * 4 + h) * NCH + cc) * 2 + dir) * 2048;
#pragma unroll
        for (int d0 = 0; d0 < 2; ++d0) {
            const bf16x8 qs = scale_bf16x8(q2[d0], s);
#pragma unroll
            for (int d = 0; d < 2; ++d) {
                const float* sp = stp + (32 * d + r32) * 32 + 16 * d0 + 8 * hi;
                const f32x4 a = *(const f32x4*)(sp), c = *(const f32x4*)(sp + 4);
                u32x4 w; w.x = cvt_pk_bf16(a[0], a[1]); w.y = cvt_pk_bf16(a[2], a[3]); w.z = cvt_pk_bf16(c[0], c[1]); w.w = cvt_pk_bf16(c[2], c[3]);
                o[d] = MFMA32(qs, __builtin_bit_cast(bf16x8, w), o[d]);
            }
        }
    }
    float s1[16], q1[16];
#pragma unroll
    for (int r = 0; r < 16; ++r) s1[r] = o[0][r] + o[1][r];
#pragma unroll
    for (int st = 1; st < 32; st <<= 1) {
#pragma unroll
        for (int r = 0; r < 16; ++r) s1[r] += __shfl_xor(s1[r], st);
    }
#pragma unroll
    for (int r = 0; r < 16; ++r) { const float mean = s1[r] * (1.0f / 64.0f); o[0][r] -= mean; o[1][r] -= mean; q1[r] = o[0][r] * o[0][r] + o[1][r] * o[1][r]; }
#pragma unroll
    for (int st = 1; st < 32; st <<= 1) {
#pragma unroll
        for (int r = 0; r < 16; ++r) q1[r] += __shfl_xor(q1[r], st);
    }
    float gg0[16], gg1[16];
    {
        const bf16_t* gp0; const bf16_t* gp1; size_t gstride;
        if (h < 2) { gp0 = P + (size_t)(tok0 + i0 + 4 * hi) * PW + PC_GR + 64 * h + r32; gp1 = gp0 + 32; gstride = PW; }
        else { gp0 = PT + (size_t)(PR_GR2 + 64 * (h - 2) + r32) * MTOT + tok0 + i0 + 4 * hi; gp1 = gp0 + (size_t)32 * MTOT; gstride = 1; }
#pragma unroll
        for (int r = 0; r < 16; ++r) { const size_t ro = (size_t)((r & 3) + 8 * (r >> 2)) * gstride; gg0[r] = bf2f(gp0[ro]); gg1[r] = bf2f(gp1[ro]); }
    }
#pragma unroll
    for (int r = 0; r < 16; ++r) {
        const float rstd = rsqrtf(q1[r] * (1.0f / 64.0f) + EPS);
        const size_t row = (size_t)(tok0 + i0 + crow(r, hi));
        mix[row * DM + 768 + 64 * h + r32] = (bf16_t)(cvt_pk_bf16(silu_f(gg0[r]) * o[0][r] * rstd, 0.f) & 0xffffu);
        mix[row * DM + 768 + 64 * h + 32 + r32] = (bf16_t)(cvt_pk_bf16(silu_f(gg1[r]) * o[1][r] * rstd, 0.f) & 0xffffu);
    }
    __syncthreads();
}

#ifndef PH_PREP
#define PH_PREP 1
#endif
#ifndef PH_NORM
#define PH_NORM 1
#endif
#ifndef PH_IN1
#define PH_IN1 1
#endif
#ifndef PH_IN2
#define PH_IN2 1
#endif
#ifndef PH_R1
#define PH_R1 1
#endif
#ifndef PH_R2
#define PH_R2 1
#endif
#ifndef PH_MIX
#define PH_MIX 1
#endif
#ifndef PH_OUT
#define PH_OUT 1
#endif
#ifndef PH_UP
#define PH_UP 1
#endif
#ifndef PH_CONV
#define PH_CONV 1
#endif
#ifndef PH_DOWN
#define PH_DOWN 1
#endif
#ifndef PH_FIN
#define PH_FIN 1
#endif
__device__ __forceinline__ void mix_phase(ldsp lds, KArgs a, int l, int G) {
    unsigned char* ws = a->ws;
    const bf16_t* P = (const bf16_t*)(ws + WS_P); const bf16_t* PT = (const bf16_t*)(ws + WS_PT);
    bf16_t* mix = (bf16_t*)(ws + WS_MIX); float* stash = a->out;
    const float* ST = (const float*)(ws + WS_ST);
    const float* scal = (const float*)(ws + WS_SCAL);
    const float lam = scal[l], lam_init = scal[2 + l];
    const float* lg = scal + 8 + l * 8;
    const int nc = (l == 0) ? 16 : 0;
    const int total = 3 * (512 + nc);
    for (int u = lbid(); u < total; u += G) {
        int v = u; int kind = 0;
        if (v >= 512 + nc) { v -= 512 + nc; kind = 1; if (v >= 512 + nc) { v -= 512 + nc; kind = 2; } }
        const bool ctx = v >= 512; if (ctx) v -= 512;
        int b, hh, qb;
        if (ctx) { b = v >> 2; hh = v & 3; qb = 0; }
        else {
            int vv = v;
            if (G == 256) { const int x = v & 7, y = (v >> 3) & 31, rnd = v >> 8; vv = (x + 8 * rnd) * 32 + y; }
            b = vv >> 7; hh = (vv >> 5) & 3; qb = vv & 31;
        }
        const int qrow0 = ctx ? NLAT + b * CTXL : b * SEQ + qb * 256;
#ifndef NO_MB
        if (kind == 0) mixb_unit(lds, P, PT, stash, mix, a->in[I_SUBG] + l * 128, lam, lam_init, b, hh, qrow0, ctx);
#endif
#ifndef NO_MA
        if (kind == 1) mixa_unit(lds, P, PT, mix, a->in[I_SINK][l * 4 + hh], b, hh, qrow0, qb * 256, ctx);
#endif
#ifndef NO_MR
        if (kind == 2) r3_unit(lds, P, PT, ST, mix, lg, b, hh, qb, ctx);
#endif
    }
}


enum { K_PREP = 0, K_NORM1, K_GEMM_IN, K_GEMM_PT, K_R1, K_R2, K_MIX, K_GEMM_OUT, K_NORM2, K_UP, K_DOWN, K_FINAL };
constexpr int NPH_L = 10, NPH = 2 + 2 * NPH_L;
__global__ void __launch_bounds__(512, 2) fwd_megakernel(Args a_unused) {
    extern __shared__ __attribute__((aligned(16))) unsigned char lds_raw[];
    ldsp lds = (ldsp)lds_raw;
    cg::grid_group grid = cg::this_grid();
    const int G = gridDim.x;
    {
        volatile LAS unsigned* st = (volatile LAS unsigned*)(lds + LDS_ST_OFF);
        if (ltid() < 2) st[ltid()] = 0u;
        __syncthreads();
        KArgs a0 = (KArgs)__builtin_amdgcn_kernarg_segment_ptr();
        (void)xcd_barrier_post((unsigned*)(a0->ws + WS_BAR), st);
    }
    if (PH_PREP) {
        KArgs a0 = (KArgs)__builtin_amdgcn_kernarg_segment_ptr();
        asm volatile("" : "+s"(a0));
        prep_phase(a0, lds, G);
        if (G > (1 << 20)) grid.sync();
        { XcdBarrier xb; xb.bar = (unsigned*)(a0->ws + WS_BAR); xb.x = xb_xcc_id(); xb.st = (volatile LAS unsigned*)(lds + LDS_ST_OFF); xcd_barrier(xb); }
    }
#pragma unroll 1
    for (int ph = 1; ph < NPH; ++ph) {
        int kind, l;
        if (ph == 0) { kind = K_PREP; l = 0; } else if (ph == NPH - 1) { kind = K_FINAL; l = 1; } else { l = (ph - 1) / NPH_L; kind = K_NORM1 + (ph - 1) % NPH_L; }
        KArgs a = (KArgs)__builtin_amdgcn_kernarg_segment_ptr();
        asm volatile("" : "+s"(a));
        unsigned char* ws = a->ws;
        float* modv = (float*)(ws + WS_MOD);
        const float* modl = modv + (size_t)l * 5 * NMOD;
        bf16_t* Xb = (bf16_t*)(ws + WS_XBF);
        bf16_t* H = (bf16_t*)(ws + WS_H);
        const bool last = (l == 1);
        const int Mffn = last ? NLAT : MTOT;
        const float* xin_l = (l == 0) ? a->in[I_X] : nullptr; const float* xin_c = (l == 0) ? a->in[I_CTX] : nullptr;
        bool sync = true;
        if (PH_NORM && (kind == K_NORM1 || kind == K_NORM2)) {
            const bool n1 = kind == K_NORM1;
            norm_phase(n1 ? xin_l : nullptr, n1 ? xin_c : nullptr, Xb, a->in[n1 ? I_N1G : I_N2G] + l * DM, modl, n1 ? 0 : 3, n1 ? 1 : 4, H, n1 ? MTOT : Mffn, G);
        } else if (PH_IN1 && kind == K_GEMM_IN) {
            const float* c64 = (const float*)(ws + WS_ROPE); const float* s64 = c64 + SEQ * 32; const float* c32 = s64 + SEQ * 32; const float* s32 = c32 + SEQ * 16;
            const bf16_t* Wt_in = (const bf16_t*)(ws + WS_WIN) + (size_t)l * 3072 * DM;
            pg8::Gemm g{H, Wt_in, MTOT, PW, DM}; pg8::StaticOrder S; S.init(MTOT, PW, G, lbid());
            EpiInTok E{(bf16_t*)(ws + WS_P), c64, s64, c32, s32};
            pg8::gemm_phase<EpiInTok, pg8::StaticOrder, true, true>(lds, g, S, E);
            sync = false;
        } else if (PH_UP && kind == K_GEMM_PT) {
            const bf16_t* Wt_in = (const bf16_t*)(ws + WS_WIN) + (size_t)l * 3072 * DM;
            pg8::Gemm g{Wt_in + (size_t)PW * DM, H, PTR, MTOT, DM}; EpiStoreBf16 E{(bf16_t*)(ws + WS_PT), MTOT};
            pg8::StaticOrder S; S.init(g.M, g.N, G, (lbid() + G - ((MTOT / 256) * (PW / 256)) % G) % G);
            pg8::gemm_phase<EpiStoreBf16, pg8::StaticOrder, true, true>(lds, g, S, E);
        } else if (PH_UP && kind == K_UP) {
            const bf16_t* Wt_up = (const bf16_t*)(ws + WS_WUP) + (size_t)l * NUP * DM;
            const int ntile = (Mffn + 247) / 248;
            pg8::Gemm g{H - DM, Wt_up, ntile * 256, NUP, DM};
            EpiUpConv E{(bf16_t*)(ws + WS_A), (const float*)(ws + WS_CWP) + (size_t)l * DFF * 8, Mffn};
            pg8::StaticOrder S; S.init(g.M, g.N, G, lbid());
            pg8::gemm_phase<EpiUpConv, pg8::StaticOrder, true, true>(lds, g, S, E);
        } else if (PH_R1 && kind == K_R1) {
            const int gw = lbid() * 8 + (ltid() >> 6), NGW = G * 8;
            const float* lg = (const float*)(ws + WS_SCAL) + 8 + l * 8;
            for (int u = gw; u < 16 * NCH; u += NGW) { const int bh = u / NCH, cc = u % NCH; r1_unit((const bf16_t*)(ws + WS_P), (const bf16_t*)(ws + WS_PT), (float*)(ws + WS_KV), lg, bh >> 2, bh & 3, cc); }
        } else if (PH_R2 && kind == K_R2) {
            r2_phase((const float*)(ws + WS_KV), (float*)(ws + WS_ST), (const float*)(ws + WS_SCAL) + 8 + l * 8, G);
        } else if (PH_MIX && kind == K_MIX) {
            mix_phase(lds, a, l, G);
        } else if (PH_OUT && (kind == K_GEMM_OUT || kind == K_DOWN)) {
            pg8::Gemm g; EpiResid E;
            if (kind == K_GEMM_OUT) {
                g = pg8::Gemm{(const bf16_t*)(ws + WS_MIX), (const bf16_t*)(ws + WS_WOUT) + (size_t)l * DM * DM, Mffn, DM, DM};
                E = EpiResid{xin_l, xin_c, Xb, modl + 2 * DM};
            } else {
                g = pg8::Gemm{(const bf16_t*)(ws + WS_A), (const bf16_t*)(ws + WS_WDN) + (size_t)l * DM * DFF, Mffn, DM, DFF};
                E = EpiResid{nullptr, nullptr, Xb, modl + 5 * DM};
            }
            pg8::StaticOrder S; S.init(g.M, g.N, G, lbid());
            pg8::gemm_phase<EpiResid, pg8::StaticOrder, true, true>(lds, g, S, E);
        } else if (PH_FIN && kind == K_FINAL) {
            final_norm_phase(Xb, a->out, a->in[I_FG], G);
            sync = false;
        }
        if (sync) { XcdBarrier xb; xb.bar = (unsigned*)(ws + WS_BAR); xb.x = xb_xcc_id(); xb.st = (volatile LAS unsigned*)(lds + LDS_ST_OFF); xcd_barrier(xb); }
    }
}

extern "C" void kernel_launch(void* const* d_in, const int* in_sizes, int n_in, void* d_out, int out_size, void* d_ws, size_t ws_size, hipStream_t stream) {
    static int grid = 0;
    if (grid == 0) {
        if (n_in != 19 || out_size != NLAT * DM || ws_size < WS_END) { fprintf(stderr, "kernel_launch: unexpected shapes: n_in %d out %d ws %zu (need %zu)\n", n_in, out_size, ws_size, (size_t)WS_END); grid = -1; return; }
        int dev = 0, cus = 0, per_cu = 0;
        if (hipGetDevice(&dev) != hipSuccess || hipDeviceGetAttribute(&cus, hipDeviceAttributeMultiprocessorCount, dev) != hipSuccess) { grid = -1; return; }
        if (hipFuncSetAttribute((const void*)fwd_megakernel, hipFuncAttributeMaxDynamicSharedMemorySize, LDS_BYTES) != hipSuccess) { fprintf(stderr, "kernel_launch: hipFuncSetAttribute failed\n"); grid = -1; return; }
        if (hipOccupancyMaxActiveBlocksPerMultiprocessor(&per_cu, (const void*)fwd_megakernel, 512, LDS_BYTES) != hipSuccess || per_cu < 1) { fprintf(stderr, "kernel_launch: occupancy query says %d\n", per_cu); per_cu = 1; }
        (void)hipGetLastError();
        grid = cus;
    }
    if (grid < 0) return;
    if (hipMemsetAsync((char*)d_ws + WS_BAR, 0, 16384, stream) != hipSuccess) { fprintf(stderr, "memset failed\n"); return; }
    Args a{};
    for (int i = 0; i < 19; ++i) a.in[i] = (const float*)d_in[i];
    a.out = (float*)d_out; a.ws = (unsigned char*)d_ws;
    void* args[] = {&a};
    hipError_t e = hipLaunchCooperativeKernel((const void*)fwd_megakernel, dim3(grid), dim3(512), args, LDS_BYTES, stream);
    if (e != hipSuccess) fprintf(stderr, "cooperative launch failed: %s (grid %d)\n", hipGetErrorString(e), grid);
}
```

```cpp
#include <hip/hip_runtime.h>
#include <hip/hip_cooperative_groups.h>
#include <cstdio>
#include <cstdint>
namespace cg = cooperative_groups;
__device__ __forceinline__ int ltid() { int t = threadIdx.x; asm volatile("" : "+v"(t)); return t; }
__device__ __forceinline__ int lbid() { int t = blockIdx.x; asm volatile("" : "+s"(t)); return t; }
namespace pg8 {
#define PG8_LAS __attribute__((address_space(3)))
typedef unsigned short bf16_t;
typedef short bf16x8 __attribute__((ext_vector_type(8)));
typedef float f32x4 __attribute__((ext_vector_type(4)));
typedef unsigned u32x4 __attribute__((ext_vector_type(4)));
constexpr int BM = 256, BK = 64, HALF = 128, HTB = HALF * BK * 2  , STAGE_BYTES = 8 * HTB, NXCD = 8, WGM = 8;

__host__ __device__ __forceinline__ int lds_byte(int r, int c) { const int st = (r >> 4) * 2 + (c >> 5), rr = r & 15, cc = c & 31, ob = rr * 64 + cc * 2; return st * 1024 + (ob ^ (((ob >> 9) & 1) << 5)); }
__host__ __device__ __forceinline__ void stage_rc(int b, int& R, int& C) { const int st = b / 1024, sb = b % 1024, swz = sb ^ (((sb >> 9) & 1) << 5); R = (st >> 1) * 16 + swz / 64; C = (st & 1) * 32 + (swz % 64) / 2; }
__host__ __device__ __forceinline__ int perm32(int rho) { const int n = rho >> 4, i = rho & 15; return 8 * (i >> 2) + 4 * n + (i & 3); }

struct Unit { int pm, pn; };
struct Gemm { const bf16_t* A; const bf16_t* Bt; int M, N, K; };

struct StaticOrder {
    int nM, nN, nwg, G, c;
    __host__ __device__ void init(int M, int N, int G_, int c_) { nM = M / BM; nN = N / BM; nwg = nM * nN; G = G_; c = c_; }
    __host__ __device__ bool next(int i, Unit& u) const {
        const long L = (long)i * G + c; if (L >= nwg) return false;
        int wgid = (int)L; { const int q = nwg / NXCD, r = nwg % NXCD, xcd = wgid % NXCD, off = wgid / NXCD; wgid = (xcd < r ? xcd * (q + 1) : r * (q + 1) + (xcd - r) * q) + off; }
        const int nig = WGM * nN, gid = wgid / nig, fm = gid * WGM, gsz = (nM - fm) < WGM ? (nM - fm) : WGM;
        u.pm = fm + ((wgid % nig) % gsz); u.pn = (wgid % nig) / gsz; return true;
    }
    __device__ __forceinline__ void a_ready(const Unit&) const {}
    __device__ __forceinline__ void done(const Unit&) const {}
};

__device__ __forceinline__ unsigned cvt_pk_bf16(float lo, float hi) { unsigned r; asm volatile("v_cvt_pk_bf16_f32 %0, %1, %2" : "=v"(r) : "v"(lo), "v"(hi)); return r; }
typedef float f32x2 __attribute__((ext_vector_type(2)));
template <class Epi, class Sched, bool ALIGN_EPI = false, bool SP2 = false>
__device__ __forceinline__ void gemm_phase(PG8_LAS unsigned char* lds, const Gemm g, const Sched& S, const Epi& E) {
    const int tid = ltid(), wid = __builtin_amdgcn_readfirstlane(tid >> 6), lane = tid & 63, wr = wid >> 2, wc = wid & 3, fr = lane & 15, fq = lane >> 4;
    const int K = g.K, nt = K / BK;
    unsigned voffA[2], voffB[2];
#pragma unroll
    for (int i = 0; i < 2; ++i) { int R, C; stage_rc(tid * 16 + i * 8192, R, C); const int Rb = Epi::PERM ? ((R & ~31) + perm32(R & 31)) : R;
        const int Ra = Epi::AREMAP ? ((R >> 6) * 62 + (R & 63)) : R; voffA[i] = (unsigned)(Ra * K + C) * 2u; voffB[i] = (unsigned)(Rb * K + C) * 2u; }
    const size_t kstep = (size_t)(BK * 2);
    const size_t hstep = (size_t)HALF * K * 2;
    const size_t tstep = 2 * hstep;
    const size_t hstepA = Epi::AREMAP ? (size_t)124 * K * 2 : hstep, tstepA = Epi::AREMAP ? (size_t)248 * K * 2 : tstep;
    const unsigned ldsw = (unsigned)wid * 1024u;
    const int aoff = lds_byte(wr * 64 + fr, fq * 8), boff = lds_byte(wc * 32 + fr, fq * 8);
#define PG8_SA(b, h) (((b) * 2 + (h)) * HTB)
#define PG8_SB(b, h) ((4 + (b) * 2 + (h)) * HTB)
#define PG8_STAGE(bufoff, gbase, voff) do { _Pragma("unroll") for (int _i = 0; _i < 2; ++_i) \
        __builtin_amdgcn_global_load_lds((const unsigned*)((const char*)(gbase) + (voff)[_i]), (PG8_LAS unsigned*)(lds + (bufoff) + ldsw + _i * 8192), 16, 0, 0); } while (0)
#define PG8_LDA(dst, b, h) do { _Pragma("unroll") for (int m = 0; m < 4; ++m) _Pragma("unroll") for (int k = 0; k < 2; ++k) dst[m][k] = *(const PG8_LAS bf16x8*)(lds + PG8_SA(b, h) + aoff + m * 2048 + k * 1024); } while (0)
#define PG8_LDB(dst, b, h) do { _Pragma("unroll") for (int n = 0; n < 2; ++n) _Pragma("unroll") for (int k = 0; k < 2; ++k) dst[n][k] = *(const PG8_LAS bf16x8*)(lds + PG8_SB(b, h) + boff + n * 2048 + k * 1024); } while (0)
#define PG8_MMA(ai, bj, At, Bt) do { __builtin_amdgcn_s_setprio(1); _Pragma("unroll") for (int m = 0; m < 4; ++m) _Pragma("unroll") for (int n = 0; n < 2; ++n) _Pragma("unroll") for (int k = 0; k < 2; ++k) \
        acc[ai][bj][m][n] = __builtin_amdgcn_mfma_f32_16x16x32_bf16(Bt[n][k], At[m][k], acc[ai][bj][m][n], 0, 0, 0); __builtin_amdgcn_s_setprio(0); } while (0)
#define PG8_WAIT_V(n) asm volatile("s_waitcnt vmcnt(" #n ")" ::: "memory")
#define PG8_WAIT_L(n) asm volatile("s_waitcnt lgkmcnt(" #n ")" ::: "memory")
#define PG8_BAR __builtin_amdgcn_s_barrier()
#define PG8_SCHED __builtin_amdgcn_sched_barrier(0)
    Unit cur, nxt; int ui = 0;
    if (!S.next(0, cur)) return;
    f32x4 acc[2][2][4][2];
#pragma unroll
    for (int a = 0; a < 2; ++a)
#pragma unroll
        for (int b = 0; b < 2; ++b)
#pragma unroll
            for (int m = 0; m < 4; ++m)
#pragma unroll
                for (int n = 0; n < 2; ++n) acc[a][b][m][n] = (f32x4){0.f, 0.f, 0.f, 0.f};
    bf16x8 At[4][2], B0[2][2], B1[2][2];
    const char* cA = (const char*)g.A + (size_t)cur.pm * tstepA; const char* cB = (const char*)g.Bt + (size_t)cur.pn * tstep;
    S.a_ready(cur);
    if constexpr (SP2) {
        PG8_STAGE(PG8_SB(0, 0), cB, voffB); PG8_STAGE(PG8_SB(0, 1), cB + hstep, voffB); PG8_STAGE(PG8_SA(0, 0), cA, voffA); PG8_STAGE(PG8_SA(0, 1), cA + hstepA, voffA);
        if (wr == 1) PG8_BAR;
        PG8_WAIT_V(2); PG8_BAR;
        PG8_STAGE(PG8_SB(1, 0), cB + kstep, voffB); PG8_STAGE(PG8_SA(1, 0), cA + kstep, voffA); PG8_STAGE(PG8_SB(1, 1), cB + hstep + kstep, voffB);
        PG8_WAIT_V(6); PG8_BAR;
    } else {
        PG8_STAGE(PG8_SB(0, 0), cB, voffB); PG8_STAGE(PG8_SA(0, 0), cA, voffA); PG8_STAGE(PG8_SB(0, 1), cB + hstep, voffB); PG8_STAGE(PG8_SA(0, 1), cA + hstepA, voffA);
        if (wr == 1) PG8_BAR;
        PG8_WAIT_V(4); PG8_BAR;
        PG8_STAGE(PG8_SB(1, 0), cB + kstep, voffB); PG8_STAGE(PG8_SA(1, 0), cA + kstep, voffA); PG8_STAGE(PG8_SB(1, 1), cB + hstep + kstep, voffB);
        PG8_WAIT_V(6); PG8_BAR;
    }
    for (;;) {
        const bool has_next = S.next(ui + 1, nxt);
        const char* nA = has_next ? (const char*)g.A + (size_t)nxt.pm * tstepA : cA; const char* nB = has_next ? (const char*)g.Bt + (size_t)nxt.pn * tstep : cB;
        for (int t = 0; t < nt; t += 2) {
            const bool last = (t == nt - 2);
            const char* a1 = cA + (size_t)(t + 1) * kstep;
            const char* a2 = last ? nA : cA + (size_t)(t + 2) * kstep; const char* b2 = last ? nB : cB + (size_t)(t + 2) * kstep;
            const char* a3 = a2 + kstep; const char* b3 = b2 + kstep;
            if (last && has_next) S.a_ready(nxt);
            if constexpr (SP2) {
            PG8_LDB(B0, 0, 0); PG8_LDB(B1, 0, 1); PG8_SCHED; PG8_LDA(At, 0, 0); PG8_STAGE(PG8_SA(1, 1), a1 + hstepA, voffA);
            PG8_WAIT_V(8); PG8_WAIT_L(0); PG8_BAR; PG8_MMA(0, 0, At, B0); PG8_MMA(0, 1, At, B1); PG8_BAR; PG8_SCHED;
            PG8_LDA(At, 0, 1); PG8_STAGE(PG8_SB(0, 0), b2, voffB); PG8_STAGE(PG8_SB(0, 1), b2 + hstep, voffB); PG8_STAGE(PG8_SA(0, 0), a2, voffA);
            PG8_WAIT_V(8); PG8_WAIT_L(0); PG8_BAR; PG8_MMA(1, 0, At, B0); PG8_MMA(1, 1, At, B1); PG8_BAR; PG8_SCHED;
            PG8_LDB(B0, 1, 0); PG8_LDB(B1, 1, 1); PG8_SCHED; PG8_LDA(At, 1, 0); PG8_STAGE(PG8_SA(0, 1), a2 + hstepA, voffA);
            PG8_WAIT_V(8); PG8_WAIT_L(0); PG8_BAR; PG8_MMA(0, 0, At, B0); PG8_MMA(0, 1, At, B1); PG8_BAR; PG8_SCHED;
            PG8_LDA(At, 1, 1); PG8_STAGE(PG8_SB(1, 0), b3, voffB); PG8_STAGE(PG8_SB(1, 1), b3 + hstep, voffB); PG8_STAGE(PG8_SA(1, 0), a3, voffA);
            PG8_WAIT_V(8); PG8_WAIT_L(0); PG8_BAR; PG8_MMA(1, 0, At, B0); PG8_MMA(1, 1, At, B1); PG8_BAR; PG8_SCHED;
            } else {
            PG8_LDB(B0, 0, 0); PG8_SCHED; PG8_LDA(At, 0, 0); PG8_STAGE(PG8_SA(1, 1), a1 + hstepA, voffA);
            PG8_WAIT_L(8); PG8_BAR; PG8_WAIT_L(0); PG8_MMA(0, 0, At, B0); PG8_BAR; PG8_SCHED;
            PG8_LDB(B1, 0, 1); PG8_STAGE(PG8_SB(0, 0), b2, voffB);
            PG8_BAR; PG8_WAIT_L(0); PG8_MMA(0, 1, At, B1); PG8_BAR;
            PG8_LDA(At, 0, 1); PG8_STAGE(PG8_SA(0, 0), a2, voffA);
            PG8_BAR; PG8_WAIT_L(0); PG8_MMA(1, 0, At, B0); PG8_BAR; PG8_SCHED;
            PG8_STAGE(PG8_SB(0, 1), b2 + hstep, voffB);
            PG8_WAIT_V(6); PG8_BAR; PG8_MMA(1, 1, At, B1); PG8_BAR;
            PG8_LDB(B0, 1, 0); PG8_SCHED; PG8_LDA(At, 1, 0); PG8_STAGE(PG8_SA(0, 1), a2 + hstepA, voffA);
            PG8_WAIT_L(8); PG8_BAR; PG8_WAIT_L(0); PG8_MMA(0, 0, At, B0); PG8_BAR; PG8_SCHED;
            PG8_LDB(B1, 1, 1); PG8_STAGE(PG8_SB(1, 0), b3, voffB);
            PG8_BAR; PG8_WAIT_L(0); PG8_MMA(0, 1, At, B1); PG8_BAR;
            PG8_LDA(At, 1, 1); PG8_STAGE(PG8_SA(1, 0), a3, voffA);
            PG8_BAR; PG8_WAIT_L(0); PG8_MMA(1, 0, At, B0); PG8_BAR; PG8_SCHED;
            PG8_STAGE(PG8_SB(1, 1), b3 + hstep, voffB);
            PG8_WAIT_V(6); PG8_BAR; PG8_MMA(1, 1, At, B1); PG8_BAR;
            }
        }
        if constexpr (ALIGN_EPI) { if (wr == 0) PG8_BAR; }
        if constexpr (!Epi::AFTER_DRAIN) { E(acc, cur, wr, wc, fr, fq); S.done(cur); }
        if (!has_next) break;
#pragma unroll
        for (int a = 0; a < 2; ++a)
#pragma unroll
            for (int b = 0; b < 2; ++b)
#pragma unroll
                for (int m = 0; m < 4; ++m)
#pragma unroll
                    for (int n = 0; n < 2; ++n) acc[a][b][m][n] = (f32x4){0.f, 0.f, 0.f, 0.f};
        cur = nxt; cA = nA; cB = nB; ++ui;
        if constexpr (ALIGN_EPI) { if (wr == 1) PG8_BAR; }
    }
    PG8_WAIT_V(0);
    if constexpr (!ALIGN_EPI) { if (wr == 0) PG8_BAR; }
    PG8_BAR;
    if constexpr (Epi::AFTER_DRAIN) { E.fused(acc, cur, wr, wc, fr, fq, lds, wid, lane); S.done(cur); }
#undef PG8_SA
#undef PG8_SB
#undef PG8_STAGE
#undef PG8_LDA
#undef PG8_LDB
#undef PG8_MMA
#undef PG8_WAIT_V
#undef PG8_WAIT_L
#undef PG8_BAR
#undef PG8_SCHED
}
}
#define LAS __attribute__((address_space(3)))
typedef LAS unsigned char* ldsp;
typedef unsigned short bf16_t;
typedef short bf16x8 __attribute__((ext_vector_type(8)));
typedef short s16x4 __attribute__((ext_vector_type(4)));
typedef float f32x4 __attribute__((ext_vector_type(4)));
typedef float f32x16 __attribute__((ext_vector_type(16)));
typedef unsigned u32x4 __attribute__((ext_vector_type(4)));
typedef unsigned u32x2 __attribute__((ext_vector_type(2)));
typedef float f32x2_t __attribute__((ext_vector_type(2))); typedef __bf16 bf16x2_t __attribute__((ext_vector_type(2)));
__device__ __forceinline__ unsigned cvt_pk_bf16(float lo, float hi) { f32x2_t v = {lo, hi}; bf16x2_t b = __builtin_convertvector(v, bf16x2_t); return __builtin_bit_cast(unsigned, b); }

constexpr int DM = 1024, NBATCH = 4, SEQ = 8192, CTXL = 256;
constexpr int NLAT = NBATCH * SEQ, NCTX = NBATCH * CTXL, MTOT = NLAT + NCTX;
constexpr int PW = 1792;
constexpr int PTR = 1024;
constexpr int DFF = 2816, NUP = 2 * DFF, NMOD = 6 * DM, INW = 2816;
constexpr int NCH = 66;
constexpr float LOG2E = 1.4426950408889634f;
constexpr float C2 = 0.125f * LOG2E;
constexpr float KRS = 0.17677669529663687f;
constexpr float EPS = 1e-6f;
constexpr int PC_QA = 0, PC_KA = 256, PC_QB = 384, PC_KB = 896, PC_QR = 1408, PC_KR = 1536, PC_GR = 1664;
constexpr int PR_VA = 0, PR_VB = 128, PR_VR = 640, PR_GR2 = 896;

constexpr size_t MiB = 1u << 20;
constexpr size_t WS_MOD = 0, WS_SCAL = 256 * 1024, CTL_ZERO = 1 * MiB;
constexpr size_t WS_WIN = 1 * MiB, WS_WOUT = 13 * MiB, WS_WUP = 17 * MiB, WS_WDN = 39 * MiB;
constexpr size_t WS_ROPE = 50 * MiB, WS_XC = 54 * MiB, WS_H = 58 * MiB;
constexpr size_t WS_P = 126 * MiB, WS_PT = 258 * MiB, WS_MIX = 324 * MiB, WS_STASH = 390 * MiB, WS_KV = 456 * MiB, WS_ST = 473 * MiB;
constexpr size_t WS_A = 126 * MiB, WS_END = 490 * MiB;
constexpr size_t WS_XBF = 390 * MiB;
constexpr int LDS_BYTES = 147456;
constexpr int LDS_ST_OFF = 131072 + 256;
constexpr size_t WS_BAR = 512 * 1024;
constexpr size_t WS_CWP = 768 * 1024;

struct Args { const float* in[19]; float* out; unsigned char* ws; };
typedef const __attribute__((address_space(4))) Args* KArgs;
enum { I_X = 0, I_C, I_CTX, I_CCTX, I_WMOD, I_BMOD, I_N1G, I_N2G, I_WIN, I_WOUT, I_SINK, I_DLAM, I_SUBG, I_RDL, I_WUP, I_CONVW, I_CONVB, I_WDN, I_FG };

__device__ __forceinline__ float bf2f(unsigned short b) { return __uint_as_float(((unsigned)b) << 16); }
__device__ __forceinline__ float bflo(unsigned w) { return __uint_as_float(w << 16); }
__device__ __forceinline__ float bfhi(unsigned w) { return __uint_as_float(w & 0xffff0000u); }
__device__ __forceinline__ float wave_sum(float v) {
#pragma unroll
    for (int o = 1; o < 64; o <<= 1) v += __shfl_xor(v, o);
    return v;
}
__device__ __forceinline__ float half_sum(float v) {
#pragma unroll
    for (int o = 1; o < 32; o <<= 1) v += __shfl_xor(v, o);
    return v;
}
__device__ __forceinline__ float silu_f(float x) { return x * __builtin_amdgcn_rcpf(1.f + __builtin_amdgcn_exp2f(-LOG2E * x)); }
__device__ __forceinline__ int crow(int r, int hi) { return (r & 3) + 8 * (r >> 2) + 4 * hi; }
__device__ __forceinline__ int mod_index(int row) { return row < NLAT ? (row >> 13) : 4; }

struct EpiStoreBf16 {
    static constexpr bool PERM = true, AFTER_DRAIN = false, AREMAP = false;
    bf16_t* O; int ldc;
    __device__ __forceinline__ void operator()(const f32x4 (&acc)[2][2][4][2], const pg8::Unit& u, int wr, int wc, int fr, int fq) const {
        const int row0 = u.pm * 256 + wr * 64 + fr, col0 = u.pn * 256 + wc * 32 + 8 * fq;
#pragma unroll
        for (int ai = 0; ai < 2; ++ai)
#pragma unroll
            for (int m = 0; m < 4; ++m) { bf16_t* rowp = O + (size_t)(row0 + ai * 128 + m * 16) * ldc + col0;
#pragma unroll
                for (int bj = 0; bj < 2; ++bj) { const f32x4 v0 = acc[ai][bj][m][0], v1 = acc[ai][bj][m][1];
                    u32x4 w; w.x = cvt_pk_bf16(v0[0], v0[1]); w.y = cvt_pk_bf16(v0[2], v0[3]); w.z = cvt_pk_bf16(v1[0], v1[1]); w.w = cvt_pk_bf16(v1[2], v1[3]);
                    *(u32x4*)(rowp + bj * 128) = w; } }
    }
};
struct EpiInTok {
    static constexpr bool PERM = true, AFTER_DRAIN = false, AREMAP = false;
    bf16_t* P; const float* c64; const float* s64; const float* c32; const float* s32;
    __device__ __forceinline__ void operator()(const f32x4 (&acc)[2][2][4][2], const pg8::Unit& u, int wr, int wc, int fr, int fq) const {
        const int row0 = u.pm * 256 + wr * 64 + fr;
        const bool lat = (u.pm * 256) < NLAT;
#pragma unroll
        for (int bj = 0; bj < 2; ++bj) {
            const int seg = 2 * u.pn + bj, cb = u.pn * 256 + bj * 128 + wc * 32 + 8 * fq;
            const int mode = (seg <= 10) ? 1 : ((seg <= 12) ? 2 : 0);
            const float sc = (seg <= 1 || (seg >= 3 && seg <= 6)) ? C2 : ((seg == 12) ? KRS : 1.f);
#pragma unroll
            for (int ai = 0; ai < 2; ++ai)
#pragma unroll
                for (int m = 0; m < 4; ++m) {
                    const int row = row0 + ai * 128 + m * 16;
                    f32x4 v0 = acc[ai][bj][m][0], v1 = acc[ai][bj][m][1];
                    if (mode != 0 && lat) {
                        const int t = row & (SEQ - 1);
                        f32x4 cs, sn;
                        if (mode == 1) { const int i0 = (cb & 63) >> 1; cs = *(const f32x4*)(c64 + t * 32 + i0); sn = *(const f32x4*)(s64 + t * 32 + i0); }
                        else { const int i0 = (cb & 31) >> 1; cs = *(const f32x4*)(c32 + t * 16 + i0); sn = *(const f32x4*)(s32 + t * 16 + i0); }
                        f32x4 a0, a1;
                        a0[0] = v0[0] * cs[0] - v0[1] * sn[0]; a0[1] = v0[0] * sn[0] + v0[1] * cs[0];
                        a0[2] = v0[2] * cs[1] - v0[3] * sn[1]; a0[3] = v0[2] * sn[1] + v0[3] * cs[1];
                        a1[0] = v1[0] * cs[2] - v1[1] * sn[2]; a1[1] = v1[0] * sn[2] + v1[1] * cs[2];
                        a1[2] = v1[2] * cs[3] - v1[3] * sn[3]; a1[3] = v1[2] * sn[3] + v1[3] * cs[3];
                        v0 = a0; v1 = a1;
                    }
                    v0 = v0 * sc; v1 = v1 * sc;
                    u32x4 w; w.x = cvt_pk_bf16(v0[0], v0[1]); w.y = cvt_pk_bf16(v0[2], v0[3]); w.z = cvt_pk_bf16(v1[0], v1[1]); w.w = cvt_pk_bf16(v1[2], v1[3]);
                    *(u32x4*)(P + (size_t)row * PW + cb) = w;
                }
        }
    }
};
struct EpiResid {
    static constexpr bool PERM = true, AFTER_DRAIN = false, AREMAP = false;
    const float* xin_lat; const float* xin_ctx; bf16_t* Xb; const float* gate;
    __device__ __forceinline__ void operator()(const f32x4 (&acc)[2][2][4][2], const pg8::Unit& u, int wr, int wc, int fr, int fq) const {
        const int rowt = u.pm * 256; const int mi = mod_index(rowt);
        const float* xi = xin_lat ? (rowt < NLAT ? xin_lat + (size_t)rowt * DM : xin_ctx + (size_t)(rowt - NLAT) * DM) : nullptr;
        bf16_t* xo = Xb + (size_t)rowt * DM;
        const int col0 = u.pn * 256 + wc * 32 + 8 * fq;
#pragma unroll
        for (int bj = 0; bj < 2; ++bj) {
            const f32x4 g0 = *(const f32x4*)(gate + (size_t)mi * NMOD + col0 + bj * 128), g1 = *(const f32x4*)(gate + (size_t)mi * NMOD + col0 + bj * 128 + 4);
#pragma unroll
            for (int ai = 0; ai < 2; ++ai)
#pragma unroll
                for (int m = 0; m < 4; ++m) {
                    const size_t off = (size_t)(ai * 128 + wr * 64 + m * 16 + fr) * DM + col0 + bj * 128;
                    f32x4 x0, x1;
                    if (xi) { x0 = *(const f32x4*)(xi + off); x1 = *(const f32x4*)(xi + off + 4); }
                    else { const u32x4 w = *(const u32x4*)(xo + off); x0 = (f32x4){bflo(w.x), bfhi(w.x), bflo(w.y), bfhi(w.y)}; x1 = (f32x4){bflo(w.z), bfhi(w.z), bflo(w.w), bfhi(w.w)}; }
                    const f32x4 y0 = x0 + g0 * acc[ai][bj][m][0], y1 = x1 + g1 * acc[ai][bj][m][1];
                    u32x4 o; o.x = cvt_pk_bf16(y0[0], y0[1]); o.y = cvt_pk_bf16(y0[2], y0[3]); o.z = cvt_pk_bf16(y1[0], y1[1]); o.w = cvt_pk_bf16(y1[2], y1[3]);
                    *(u32x4*)(xo + off) = o;
                }
        }
    }
};

__device__ __forceinline__ float dpp_ror1(float v) { return __int_as_float(__builtin_amdgcn_update_dpp(0, __float_as_int(v), 0x121, 0xf, 0xf, false)); }
__device__ __forceinline__ float dpp_ror15(float v) { return __int_as_float(__builtin_amdgcn_update_dpp(0, __float_as_int(v), 0x12F, 0xf, 0xf, false)); }
__device__ __forceinline__ bool seq_first(int row) { return row < NLAT ? ((row & (SEQ - 1)) == 0) : (((row - NLAT) & (CTXL - 1)) == 0); }
struct EpiUpConv {
    static constexpr bool PERM = true, AFTER_DRAIN = false, AREMAP = true;
    bf16_t* A; const float* cw; int M;
    __device__ __forceinline__ void operator()(const f32x4 (&acc)[2][2][4][2], const pg8::Unit& u, int wr, int wc, int fr_, int fq_) const {
        int fr = fr_, fq = fq_; asm volatile("" : "+v"(fr), "+v"(fq));
        const int lane = fq * 16 + fr;
        const int srcp = (lane & 48) | ((fr + 15) & 15), srcn = (lane & 48) | ((fr + 1) & 15);
        const int chb = u.pn * 128 + wc * 32 + 8 * fq;
#pragma unroll
        for (int n = 0; n < 2; ++n) {
            const int ch = chb + 4 * n;
            f32x4 wvs[4], wgs[4];
#pragma unroll
            for (int e = 0; e < 4; ++e) { wvs[e] = *(const f32x4*)(cw + (size_t)(ch + e) * 8); wgs[e] = *(const f32x4*)(cw + (size_t)(ch + e) * 8 + 4); }
#pragma unroll
            for (int ai = 0; ai < 2; ++ai) {
                const int rowbase = u.pm * 248 + 62 * (2 * ai + wr) - 1;
                float ov[4][4]; int sp_ = srcp, sn_ = srcn;
#pragma unroll
                for (int e = 0; e < 4; ++e) {
                    const f32x4 wva = wvs[e], wga = wgs[e];
                    const float wv0 = wva[0], wv1 = wva[1], wv2 = wva[2], bv = wva[3], wg0 = wga[0], wg1 = wga[1], wg2 = wga[2], bg = wga[3];
#pragma unroll
                    for (int m = 0; m < 4; ++m) {
                        const int t = rowbase + 16 * m + fr;
                        const float cv = acc[ai][0][m][n][e], cg = acc[ai][1][m][n][e];
                        const float cvm = m > 0 ? acc[ai][0][m > 0 ? m - 1 : 0][n][e] : 0.f, cgm = m > 0 ? acc[ai][1][m > 0 ? m - 1 : 0][n][e] : 0.f;
                        const float cvp = m < 3 ? acc[ai][0][m < 3 ? m + 1 : 3][n][e] : 0.f, cgp = m < 3 ? acc[ai][1][m < 3 ? m + 1 : 3][n][e] : 0.f;
                        float pv = dpp_ror1(fr == 15 ? cvm : cv), pg = dpp_ror1(fr == 15 ? cgm : cg);
                        float nv = dpp_ror15(fr == 0 ? cvp : cv), ng = dpp_ror15(fr == 0 ? cgp : cg);
                        if (seq_first(t)) { pv = 0.f; pg = 0.f; }
                        if (seq_first(t + 1)) { nv = 0.f; ng = 0.f; }
                        const float val = wv0 * pv + wv1 * cv + wv2 * nv + bv;
                        const float gat = wg0 * pg + wg1 * cg + wg2 * ng + bg;
                        ov[m][e] = silu_f(gat) * val;
                        __builtin_amdgcn_sched_barrier(0);
                    }
                    if (e == 3) asm volatile("" : "+v"(ov[0][0]), "+v"(ov[1][0]), "+v"(ov[2][0]), "+v"(ov[3][0]), "+v"(ov[0][1]), "+v"(ov[1][1]), "+v"(ov[2][1]), "+v"(ov[3][1]), "+v"(ov[0][2]), "+v"(ov[1][2]), "+v"(ov[2][2]), "+v"(ov[3][2]), "+v"(ov[0][3]), "+v"(ov[1][3]), "+v"(ov[2][3]), "+v"(ov[3][3]), "+v"(sp_), "+v"(sn_));
                }
#pragma unroll
                for (int m = 0; m < 4; ++m) {
                    const int rho = 16 * m + fr, t = rowbase + rho;
                    if (rho >= 1 && rho <= 62 && t < M) { u32x2 w; w.x = cvt_pk_bf16(ov[m][0], ov[m][1]); w.y = cvt_pk_bf16(ov[m][2], ov[m][3]); *(u32x2*)(A + (size_t)t * DFF + ch) = w; }
                }
            }
        }
    }
};
#define XB_TMO      128
#define XB_XCNT(j)  (256  + 64 * (j))
#define XB_XSUB(j)  (1280 + 64 * (j))
#define XB_XGEN(j)  (2304 + 64 * (j))
#define XB_TOP      3328
#define XB_TOPGEN   3392
#define XCD_BAR_WORDS 3456
#define XB_SPIN_CAP (1u << 18)

__device__ __forceinline__ unsigned xb_ld(unsigned* p)              { return __hip_atomic_load(p, __ATOMIC_RELAXED, __HIP_MEMORY_SCOPE_AGENT); }
__device__ __forceinline__ unsigned xb_add(unsigned* p, unsigned v) { return __hip_atomic_fetch_add(p, v, __ATOMIC_RELAXED, __HIP_MEMORY_SCOPE_AGENT); }
__device__ __forceinline__ unsigned xb_xcc_id() { return (unsigned)__builtin_amdgcn_s_getreg((3 << 11) | 20) & 0xFu; }
#define XB_SPIN(cond, bar) do { unsigned _sp = 0; while (cond) { __builtin_amdgcn_s_sleep(1); \
    if ((++_sp & 255u) == 0u) { if (xb_ld(&(bar)[XB_TMO])) break; if (_sp > XB_SPIN_CAP) { atomicAdd(&(bar)[XB_TMO], 1u); break; } } } } while (0)

struct XcdBarrier {
    unsigned* bar; unsigned x;
    volatile LAS unsigned* st;
};

__device__ __forceinline__ XcdBarrier xcd_barrier_post(unsigned* bar, volatile LAS unsigned* st) {
    XcdBarrier b; b.bar = bar; b.x = xb_xcc_id(); b.st = st;
    if (threadIdx.x == 0) (void)xb_add(&bar[XB_XCNT(b.x)], 1u);
    return b;
}
__device__ __forceinline__ void xcd_barrier_complete(unsigned* bar, unsigned x, unsigned& nloc, unsigned& nx) {
    const unsigned G = gridDim.x * gridDim.y * gridDim.z;
    unsigned sum, cnt, mine, sp = 0u;
    for (;;) {
        sum = 0u; cnt = 0u; mine = 0u;
#pragma unroll
        for (unsigned j = 0; j < 16; ++j) { const unsigned c = xb_ld(&bar[XB_XCNT(j)]); sum += c; cnt += (c > 0u) ? 1u : 0u; mine = (j == x) ? c : mine; }
        if (sum == G) break;
        __builtin_amdgcn_s_sleep(1);
        if ((++sp & 255u) == 0u) { if (xb_ld(&bar[XB_TMO])) break; if (sp > XB_SPIN_CAP) { atomicAdd(&bar[XB_TMO], 1u); break; } }
    }
    nloc = mine > 0u ? mine : 1u; nx = cnt > 0u ? cnt : 1u;
}

__device__ __forceinline__ void xcd_barrier(const XcdBarrier& b) {
    asm volatile("s_waitcnt vmcnt(0)" ::: "memory");
    __syncthreads();
    if (threadIdx.x == 0) {
        unsigned* bar = b.bar;
        __builtin_amdgcn_s_waitcnt(0);
        unsigned nloc = b.st[0], nx = b.st[1];
        if (nloc == 0u) { xcd_barrier_complete(bar, b.x, nloc, nx); b.st[0] = nloc; b.st[1] = nx; }
        const unsigned old = xb_add(&bar[XB_XSUB(b.x)], 1u);
        const unsigned gen = old / nloc;
        if (old + 1u == (gen + 1u) * nloc) {
            __builtin_amdgcn_fence(__ATOMIC_RELEASE, "agent");
            asm volatile("s_waitcnt vmcnt(0)" ::: "memory");
            const unsigned og = xb_add(&bar[XB_TOP], 1u);
            const unsigned tg = og / nx;
            if (og + 1u == (tg + 1u) * nx) xb_add(&bar[XB_TOPGEN], 1u);
            else XB_SPIN(xb_ld(&bar[XB_TOPGEN]) == tg, bar);
            __builtin_amdgcn_fence(__ATOMIC_ACQUIRE, "agent");
            xb_add(&bar[XB_XGEN(b.x)], 1u);
            asm volatile("s_waitcnt vmcnt(0)" ::: "memory");
        } else {
            XB_SPIN(xb_ld(&bar[XB_XGEN(b.x)]) == gen, bar);
            __builtin_amdgcn_fence(__ATOMIC_ACQUIRE, "agent");
            asm volatile("s_waitcnt vmcnt(0)" ::: "memory");
        }
    }
    __syncthreads();
}
__device__ __forceinline__ int src_in(int r) {
    if (r < PW) {
        int d, s, hd;
        if (r < 256) { d = 0; s = 0; hd = 64; }
        else if (r < 384) { d = 256; s = 256; hd = 64; }
        else if (r < 896) { d = 384; s = 512; hd = 64; }
        else if (r < 1408) { d = 896; s = 1024; hd = 64; }
        else if (r < 1536) { d = 1408; s = 2048; hd = 32; }
        else if (r < 1664) { d = 1536; s = 2176; hd = 32; }
        else { d = 1664; s = 2560; hd = 0; }
        int jl = r - d;
        if (hd) { const int head = jl / hd, p = jl % hd; jl = head * hd + (p & 1) * (hd / 2) + (p >> 1); }
        return s + jl;
    }
    const int q = r - PW;
    if (q < 128) return 384 + q;
    if (q < 640) return 1536 + (q - 128);
    if (q < 896) return 2304 + (q - 640);
    return 2560 + 128 + (q - 896);
}
__device__ __forceinline__ void transpose_item(const float* W, int K, int N, bf16_t* WT, int inmap, volatile LAS float* scr, int item, int nblk, int lane) {
    const int kb = item / nblk, nb = item % nblk, k0 = 64 * kb, n0 = 32 * nb;
    const int nn = n0 + (lane & 31); const int sc = inmap == 1 ? src_in(nn) : (inmap == 2 ? (((nn & 255) < 128) ? 128 * (nn >> 8) + (nn & 255) : DFF + 128 * (nn >> 8) + (nn & 255) - 128) : nn);
#pragma unroll 8
    for (int i = 0; i < 32; ++i) { const int kk = 2 * i + (lane >> 5); scr[kk * 33 + (lane & 31)] = sc >= 0 ? W[(size_t)(k0 + kk) * N + sc] : 0.f; }
    const int c = lane & 7;
#pragma unroll
    for (int j = 0; j < 4; ++j) { const int n = (lane >> 3) + 8 * j; volatile LAS float* s = scr + (8 * c) * 33 + n;
        u32x4 o; o.x = cvt_pk_bf16(s[0 * 33], s[1 * 33]); o.y = cvt_pk_bf16(s[2 * 33], s[3 * 33]); o.z = cvt_pk_bf16(s[4 * 33], s[5 * 33]); o.w = cvt_pk_bf16(s[6 * 33], s[7 * 33]);
        *(u32x4*)(WT + (size_t)(n0 + n) * K + k0 + 8 * c) = o; }
}
__device__ __forceinline__ float inv_freq(int j, int nf) {
    const int jj = (nf == 16) ? j : 2 * j;
    const int q = jj >> 2, r = jj & 3;
    const float b = r == 0 ? 1.0f : (r == 1 ? 0.5623413251903491f : (r == 2 ? 0.31622776601683794f : 0.17782794100389228f));
    const float p = q == 0 ? 1.0f : (q == 1 ? 0.1f : (q == 2 ? 0.01f : 0.001f));
    return b * p;
}
__device__ __forceinline__ void prep_phase(KArgs a, ldsp lds, int G) {
    const int tid = ltid(), lane = tid & 63, wid = tid >> 6, bid = lbid();
    unsigned char* ws = a->ws;
    float* modv = (float*)(ws + WS_MOD);
    {
        volatile LAS float* sl = (volatile LAS float*)(lds);
        volatile LAS float* red = (volatile LAS float*)(lds + 5 * 1024 * 4);
        for (int i = tid; i < 5 * DM; i += 512) sl[i] = silu_f(i < 4 * DM ? a->in[I_C][i] : a->in[I_CCTX][i - 4 * DM]);
        __syncthreads();
        const int kc = tid >> 5, j = tid & 31;
        for (int item = bid; item < 2 * 192; item += G) {
            const int l = item / 192, nb = item % 192, n = nb * 32 + j;
            float acc[5] = {0.f, 0.f, 0.f, 0.f, 0.f};
            const float* wm = a->in[I_WMOD] + ((size_t)l * DM + kc * 64) * NMOD + n;
#pragma unroll 8
            for (int kk = 0; kk < 64; ++kk) {
                const float w = wm[(size_t)kk * NMOD];
#pragma unroll
                for (int mi = 0; mi < 5; ++mi) acc[mi] += sl[mi * DM + kc * 64 + kk] * w;
            }
#pragma unroll
            for (int mi = 0; mi < 5; ++mi) red[(kc * 5 + mi) * 32 + j] = acc[mi];
            __syncthreads();
            if (tid < 160) {
                const int mi = tid >> 5;
                float s = a->in[I_BMOD][l * NMOD + n];
#pragma unroll
                for (int q = 0; q < 16; ++q) s += red[(q * 5 + mi) * 32 + j];
                modv[(size_t)(l * 5 + mi) * NMOD + n] = s;
            }
            __syncthreads();
        }
    }
    if (bid == 0) {
        float* scal = (float*)(ws + WS_SCAL);
        if (tid < 2) {
            const float* dl = a->in[I_DLAM] + tid * 256;
            float s1 = 0.f, s2 = 0.f;
            for (int i = 0; i < 64; ++i) { s1 += dl[i] * dl[64 + i]; s2 += dl[128 + i] * dl[192 + i]; }
            const float lam_init = 0.8f - 0.6f * expf(-0.3f * (float)tid);
            scal[tid] = expf(s1) - expf(s2) + lam_init;
            scal[2 + tid] = lam_init;
        } else if (tid >= 64 && tid < 80) {
            const int i = tid - 64;
            const float x = a->in[I_RDL][i];
            scal[8 + i] = -log1pf(expf(-x)) * LOG2E;
        }
    }
    {
        float* cwp = (float*)(ws + WS_CWP);
        for (int i = bid * 512 + tid; i < 2 * DFF; i += G * 512) {
            const int l = i / DFF, ch = i % DFF;
            const float* w = a->in[I_CONVW] + (size_t)l * 3 * NUP; const float* b = a->in[I_CONVB] + (size_t)l * NUP;
            f32x4 va = {w[ch], w[NUP + ch], w[2 * NUP + ch], b[ch]}, ga = {w[DFF + ch], w[NUP + DFF + ch], w[2 * NUP + DFF + ch], b[DFF + ch]};
            *(f32x4*)(cwp + (size_t)i * 8) = va; *(f32x4*)(cwp + (size_t)i * 8 + 4) = ga;
        }
    }
    {
        float* c64 = (float*)(ws + WS_ROPE); float* s64 = c64 + SEQ * 32; float* c32 = s64 + SEQ * 32; float* s32 = c32 + SEQ * 16;
        for (int e = bid * 512 + tid; e < SEQ * 48; e += G * 512) {
            const int t = e / 48, i = e % 48;
            float ang;
            if (i < 32) { const float pos = (float)((i < 16) ? (t >> 6) : (t & 63)); ang = pos * inv_freq(i & 15, 16); }
            else { const int ii = i - 32; const float pos = (float)((ii < 8) ? (t >> 6) : (t & 63)); ang = pos * inv_freq(ii & 7, 8); }
            double rv = (double)ang * 0.15915494309189535; rv -= rint(rv);
            const float rr = (float)rv;
            const float sn = __builtin_amdgcn_sinf(rr), cs = __builtin_amdgcn_cosf(rr);
            if (i < 32) { c64[t * 32 + i] = cs; s64[t * 32 + i] = sn; } else { c32[t * 16 + i - 32] = cs; s32[t * 16 + i - 32] = sn; }
        }
    }
    {
        volatile LAS float* scr = (volatile LAS float*)(lds + wid * 16384);
        const int gw = bid * 8 + wid, NGW = G * 8;
        constexpr int I_IN = 16 * 88, I_OUT = 16 * 32, I_UP = 16 * 176, I_DN = 44 * 32, I_L = I_IN + I_OUT + I_UP + I_DN;
        for (int it = gw; it < 2 * I_L; it += NGW) {
            const int l = it / I_L; int r = it % I_L;
            if (r < I_IN) { transpose_item(a->in[I_WIN] + (size_t)l * DM * INW, DM, INW, (bf16_t*)(ws + WS_WIN) + (size_t)l * 3072 * DM, 1, scr, r, 88, lane); continue; } r -= I_IN;
            if (r < I_OUT) { transpose_item(a->in[I_WOUT] + (size_t)l * DM * DM, DM, DM, (bf16_t*)(ws + WS_WOUT) + (size_t)l * DM * DM, 0, scr, r, 32, lane); continue; } r -= I_OUT;
            if (r < I_UP) { transpose_item(a->in[I_WUP] + (size_t)l * DM * NUP, DM, NUP, (bf16_t*)(ws + WS_WUP) + (size_t)l * NUP * DM, 2, scr, r, 176, lane); continue; } r -= I_UP;
            transpose_item(a->in[I_WDN] + (size_t)l * DFF * DM, DFF, DM, (bf16_t*)(ws + WS_WDN) + (size_t)l * DM * DFF, 0, scr, r, 32, lane);
        }
    }
}
constexpr int NRW = 4;
__device__ __forceinline__ void norm_phase(const float* xl, const float* xc, const bf16_t* Xb, const float* g, const float* modl, int shi, int sci, bf16_t* H, int M, int G) {
    const int tid = ltid(), lane = tid & 63, wid = tid >> 6;
    const int gw = lbid() * 8 + wid, NGW = G * 8;
    for (int row0 = gw; row0 < M; row0 += NRW * NGW) {
        f32x4 v[NRW][4]; float ss[NRW];
#pragma unroll
        for (int q = 0; q < NRW; ++q) {
            const int row = row0 + q * NGW;
            if (row < M) {
                if (xl) {
                    const float* xr = row < NLAT ? xl + (size_t)row * DM : xc + (size_t)(row - NLAT) * DM;
#pragma unroll
                    for (int j = 0; j < 2; ++j) { v[q][2 * j] = *(const f32x4*)(xr + 512 * j + 8 * lane); v[q][2 * j + 1] = *(const f32x4*)(xr + 512 * j + 8 * lane + 4); }
                } else {
#pragma unroll
                    for (int j = 0; j < 2; ++j) { const u32x4 w = *(const u32x4*)(Xb + (size_t)row * DM + 512 * j + 8 * lane);
                        v[q][2 * j] = (f32x4){bflo(w.x), bfhi(w.x), bflo(w.y), bfhi(w.y)}; v[q][2 * j + 1] = (f32x4){bflo(w.z), bfhi(w.z), bflo(w.w), bfhi(w.w)}; }
                }
            } else {
#pragma unroll
                for (int j = 0; j < 4; ++j) v[q][j] = (f32x4){0.f, 0.f, 0.f, 0.f};
            }
        }
#pragma unroll
        for (int q = 0; q < NRW; ++q) { float s = 0.f;
#pragma unroll
            for (int j = 0; j < 4; ++j) s += (v[q][j][0] * v[q][j][0] + v[q][j][1] * v[q][j][1]) + (v[q][j][2] * v[q][j][2] + v[q][j][3] * v[q][j][3]);
            ss[q] = s; }
#pragma unroll
        for (int o = 1; o < 64; o <<= 1) {
#pragma unroll
            for (int q = 0; q < NRW; ++q) ss[q] += __shfl_xor(ss[q], o);
        }
#pragma unroll
        for (int q = 0; q < NRW; ++q) {
            const int row = row0 + q * NGW;
            if (row < M) {
                const int mi = mod_index(row);
                const float rstd = rsqrtf(ss[q] * (1.f / DM) + EPS);
#pragma unroll
                for (int j = 0; j < 2; ++j) {
                    u32x4 o;
#pragma unroll
                    for (int h = 0; h < 2; ++h) {
                        const int col = 512 * j + 8 * lane + 4 * h;
                        const f32x4 gg = *(const f32x4*)(g + col);
                        const f32x4 sc = *(const f32x4*)(modl + (size_t)mi * NMOD + sci * DM + col);
                        const f32x4 sh = *(const f32x4*)(modl + (size_t)mi * NMOD + shi * DM + col);
                        const f32x4 y = (v[q][2 * j + h] * rstd) * gg * (sc + 1.0f) + sh;
                        if (h == 0) { o.x = cvt_pk_bf16(y[0], y[1]); o.y = cvt_pk_bf16(y[2], y[3]); } else { o.z = cvt_pk_bf16(y[0], y[1]); o.w = cvt_pk_bf16(y[2], y[3]); }
                    }
                    *(u32x4*)(H + (size_t)row * DM + 512 * j + 8 * lane) = o;
                }
            }
        }
    }
}
__device__ __forceinline__ void final_norm_phase(const bf16_t* Xb, float* out, const float* g, int G) {
    const int tid = ltid(), lane = tid & 63, wid = tid >> 6;
    const int gw = lbid() * 8 + wid, NGW = G * 8;
    f32x4 gq[4];
#pragma unroll
    for (int j = 0; j < 4; ++j) gq[j] = *(const f32x4*)(g + 512 * (j >> 1) + 8 * lane + 4 * (j & 1));
    for (int row0 = gw; row0 < NLAT; row0 += NRW * NGW) {
        f32x4 v[NRW][4]; float ss[NRW];
#pragma unroll
        for (int q = 0; q < NRW; ++q) {
            const int row = row0 + q * NGW;
#pragma unroll
            for (int j = 0; j < 2; ++j) {
                u32x4 w = {0u, 0u, 0u, 0u};
                if (row < NLAT) w = *(const u32x4*)(Xb + (size_t)row * DM + 512 * j + 8 * lane);
                v[q][2 * j] = (f32x4){bflo(w.x), bfhi(w.x), bflo(w.y), bfhi(w.y)}; v[q][2 * j + 1] = (f32x4){bflo(w.z), bfhi(w.z), bflo(w.w), bfhi(w.w)};
            }
        }
#pragma unroll
        for (int q = 0; q < NRW; ++q) { float s = 0.f;
#pragma unroll
            for (int j = 0; j < 4; ++j) s += (v[q][j][0] * v[q][j][0] + v[q][j][1] * v[q][j][1]) + (v[q][j][2] * v[q][j][2] + v[q][j][3] * v[q][j][3]);
            ss[q] = s; }
#pragma unroll
        for (int o = 1; o < 64; o <<= 1) {
#pragma unroll
            for (int q = 0; q < NRW; ++q) ss[q] += __shfl_xor(ss[q], o);
        }
#pragma unroll
        for (int q = 0; q < NRW; ++q) {
            const int row = row0 + q * NGW;
            if (row < NLAT) {
                const float rstd = rsqrtf(ss[q] * (1.f / DM) + EPS);
#pragma unroll
                for (int j = 0; j < 4; ++j) { const int col = 512 * (j >> 1) + 8 * lane + 4 * (j & 1); *(f32x4*)(out + (size_t)row * DM + col) = (v[q][j] * rstd) * gq[j]; }
            }
        }
    }
}
__device__ __forceinline__ float max3f(float a, float b, float c) { float r; asm("v_max3_f32 %0, %1, %2, %3" : "=v"(r) : "v"(a), "v"(b), "v"(c)); return r; }
#define MFMA32(a, b, c) __builtin_amdgcn_mfma_f32_32x32x16_bf16((a), (b), (c), 0, 0, 0)
struct AttnSeg { const bf16_t* Kc; const bf16_t* Kl; const bf16_t* Vc; const bf16_t* Vl; int nctx, t0, t1; };
constexpr int ATT_KB = 64 * 144;
constexpr int ATT_VS = 144;
constexpr int ATT_VB = 128 * ATT_VS;
constexpr int ATT_VOFF = 2 * ATT_KB;
constexpr int ATT_WSF = ATT_VOFF + 3 * ATT_VB;

template <int DV, bool WIN>
__device__ __forceinline__ void attn_pass(ldsp lds, const AttnSeg& S, const bf16x8 (&qr)[4], int qpos, f32x16 (&o)[DV / 32], float& m, float& l) {
    const int tid = ltid(), lane = tid & 63, r32 = lane & 31, hi = lane >> 5, wid = __builtin_amdgcn_readfirstlane(tid >> 6);
    constexpr int NV = DV / 64, ND = DV / 32;
    constexpr int EPG = (DV == 128) ? 2 : 4;
    volatile LAS float* wsf = (volatile LAS float*)(lds + ATT_WSF) + wid * 64;
    const int NT = S.nctx + (S.t1 - S.t0);
    const int krow = tid >> 3, kch = tid & 7;
    u32x4 sk; u32x4 sv[NV];
#define SB() __builtin_amdgcn_sched_barrier(0)
#define ATT_LOAD(i) do { const int _i = (i); const bf16_t* kp; const bf16_t* vp; \
        if (_i < S.nctx) { kp = S.Kc + (size_t)_i * 64 * PW; vp = S.Vc + _i * 64; } else { const int _t = S.t0 + _i - S.nctx; kp = S.Kl + (size_t)_t * 64 * PW; vp = S.Vl + _t * 64; } \
        sk = *(const u32x4*)(kp + (size_t)krow * PW + kch * 8); \
        _Pragma("unroll") for (int j = 0; j < NV; ++j) { const int idx = tid + 512 * j; sv[j] = *(const u32x4*)(vp + (size_t)(idx >> 3) * MTOT + (idx & 7) * 8); } } while (0)
#define ATT_STORE(kbuf, vbuf) do { *(LAS u32x4*)(lds + (kbuf) * ATT_KB + krow * 144 + kch * 16) = sk; \
        _Pragma("unroll") for (int j = 0; j < NV; ++j) { const int idx = tid + 512 * j; const int c_ = idx & 7; ldsp vq = lds + ATT_VOFF + (vbuf) * ATT_VB + (idx >> 3) * ATT_VS + (c_ >> 1) * 32 + (c_ & 1) * 8; \
            *(LAS u32x2*)(vq) = (u32x2){sv[j].x, sv[j].y}; *(LAS u32x2*)(vq + 16) = (u32x2){sv[j].z, sv[j].w}; } } while (0)
#define ATT_VLOAD(dst, Vb_, dblk) do { _Pragma("unroll") for (int j = 0; j < 4; ++j) dst[j] = *(const LAS bf16x8*)((Vb_) + (32 * (dblk) + r32) * ATT_VS + (16 * j + 8 * hi) * 2); } while (0)
#define ATT_KLOAD(Kb_) do { _Pragma("unroll") for (int d0 = 0; d0 < 4; ++d0) { kf[2 * d0] = *(const LAS bf16x8*)((Kb_) + r32 * 144 + (d0 * 16 + hi * 8) * 2); \
            kf[2 * d0 + 1] = *(const LAS bf16x8*)((Kb_) + (32 + r32) * 144 + (d0 * 16 + hi * 8) * 2); } } while (0)
#define EL(X0, X1, e) ((e) < 16 ? X0[(e) & 15] : X1[(e) & 15])
#define ATT_QK(C0, C1, P0, P1, Kb_, PREV) do { bf16x8 kf[8]; ATT_KLOAD(Kb_); SB(); float sacc = 0.f; \
        _Pragma("unroll") for (int q = 0; q < 8; ++q) { \
            if (q == 0) C0 = MFMA32(kf[0], qr[0], zero16); else if (q == 1) C1 = MFMA32(kf[1], qr[0], zero16); \
            else if ((q & 1) == 0) C0 = MFMA32(kf[q], qr[q >> 1], C0); else C1 = MFMA32(kf[q], qr[q >> 1], C1); \
            if (PREV) { sacc += EL(P0, P1, 4 * q) + EL(P0, P1, 4 * q + 1); sacc += EL(P0, P1, 4 * q + 2) + EL(P0, P1, 4 * q + 3); \
                pw[2 * q] = cvt_pk_bf16(EL(P0, P1, 4 * q), EL(P0, P1, 4 * q + 1)); pw[2 * q + 1] = cvt_pk_bf16(EL(P0, P1, 4 * q + 2), EL(P0, P1, 4 * q + 3)); } \
            SB(); } \
        if (PREV) l += sacc; } while (0)
#define PAF(j) __builtin_bit_cast(bf16x8, (u32x4){pw[4 * (j)], pw[4 * (j) + 1], pw[4 * (j) + 2], pw[4 * (j) + 3]})
#define ATT_MAX(C0, C1, I) do { \
        if (WIN && (I) >= S.nctx) { const int kp0 = (S.t0 + (I) - S.nctx) * 64 - qpos; \
            _Pragma("unroll") for (int r = 0; r < 16; ++r) { const int dlt = kp0 + crow(r, hi); if (dlt > 128 || dlt < -128) C0[r] = -1e30f; if (dlt + 32 > 128 || dlt + 32 < -128) C1[r] = -1e30f; } } \
        asm volatile("s_nop 15\n\ts_nop 7" : "+v"(C0), "+v"(C1)); \
        float mx = max3f(C0[0], C0[1], C1[0]), mx2 = max3f(C0[2], C0[3], C1[1]); mx = max3f(mx, C1[2], C1[3]); \
        _Pragma("unroll") for (int r = 4; r < 16; r += 4) { mx = max3f(mx, C0[r], C0[r + 1]); mx2 = max3f(mx2, C0[r + 2], C0[r + 3]); mx = max3f(mx, C1[r], C1[r + 1]); mx2 = max3f(mx2, C1[r + 2], C1[r + 3]); } \
        mx = fmaxf(mx, mx2); mx = fmaxf(mx, __shfl_xor(mx, 32)); \
        mnew = (mx > m + 8.0f) ? mx : m; alpha = __builtin_amdgcn_exp2f(m - mnew); } while (0)
#define ATT_EXP(C0, C1, e) do { if ((e) < 16) C0[(e) & 15] = __builtin_amdgcn_exp2f(C0[(e) & 15] - mnew); else C1[(e) & 15] = __builtin_amdgcn_exp2f(C1[(e) & 15] - mnew); } while (0)
#define ATT_PVX(C0, C1, Vb_, DOEXP) do { bf16x8 va[4], vb[4]; ATT_VLOAD(va, Vb_, 0); ATT_VLOAD(vb, Vb_, 1); SB(); \
        _Pragma("unroll") for (int j = 0; j < 4; ++j) { o[0] = MFMA32(PAF(j), va[j], o[0]); if (DOEXP) { _Pragma("unroll") for (int x = 0; x < EPG; ++x) ATT_EXP(C0, C1, EPG * j + x); asm volatile("" : "+v"(C0), "+v"(C1)); } SB(); } \
        if constexpr (DV == 128) { ATT_VLOAD(va, Vb_, 2); SB(); } \
        _Pragma("unroll") for (int j = 0; j < 4; ++j) { o[1] = MFMA32(PAF(j), vb[j], o[1]); if (DOEXP) { _Pragma("unroll") for (int x = 0; x < EPG; ++x) ATT_EXP(C0, C1, EPG * (4 + j) + x); asm volatile("" : "+v"(C0), "+v"(C1)); } SB(); } \
        if constexpr (DV == 128) { ATT_VLOAD(vb, Vb_, 3); SB(); \
            _Pragma("unroll") for (int j = 0; j < 4; ++j) { o[2] = MFMA32(PAF(j), va[j], o[2]); if (DOEXP) { _Pragma("unroll") for (int x = 0; x < EPG; ++x) ATT_EXP(C0, C1, EPG * (8 + j) + x); asm volatile("" : "+v"(C0), "+v"(C1)); } SB(); } \
            _Pragma("unroll") for (int j = 0; j < 4; ++j) { o[3] = MFMA32(PAF(j), vb[j], o[3]); if (DOEXP) { _Pragma("unroll") for (int x = 0; x < EPG; ++x) ATT_EXP(C0, C1, EPG * (12 + j) + x); asm volatile("" : "+v"(C0), "+v"(C1)); } SB(); } } } while (0)
#define ATT_RESCALE() do { if (__any(alpha != 1.0f)) { if (hi == 0) wsf[r32] = alpha; \
            _Pragma("unroll") for (int r = 0; r < 16; ++r) { const float a_ = wsf[crow(r, hi)]; _Pragma("unroll") for (int d = 0; d < ND; ++d) o[d][r] *= a_; } \
            l *= alpha; } m = mnew; } while (0)
#define ATT_TAIL(I) do { if (more) ATT_STORE(((I) + 1) & 1, vnext); __syncthreads(); vprev = vcur; vcur = vnext; vnext = (vnext == 2) ? 0 : vnext + 1; } while (0)
#define ATT_ITER(C0, C1, P0, P1, I) do { const bool more = ((I) + 1) < NT; if (more) ATT_LOAD((I) + 1); \
        ldsp Kb_ = lds + ((I) & 1) * ATT_KB; ldsp Vp_ = lds + ATT_VOFF + vprev * ATT_VB; \
        ATT_QK(C0, C1, P0, P1, Kb_, true); \
        ATT_MAX(C0, C1, I); SB(); \
        ATT_PVX(C0, C1, Vp_, true); \
        ATT_RESCALE(); ATT_TAIL(I); } while (0)
    f32x16 zero16;
#pragma unroll
    for (int r = 0; r < 16; ++r) zero16[r] = 0.f;
    f32x16 pA0, pA1, pB0, pB1;
    unsigned pw[16];
    float mnew, alpha;
    int vprev = 2, vcur = 0, vnext = 1;
    ATT_LOAD(0); ATT_STORE(0, 0);
    __syncthreads();
    {
        const bool more = 1 < NT; if (more) ATT_LOAD(1);
        ldsp Kb_ = lds;
        ATT_QK(pA0, pA1, pB0, pB1, Kb_, false);
        ATT_MAX(pA0, pA1, 0);
#pragma unroll
        for (int e = 0; e < 32; ++e) ATT_EXP(pA0, pA1, e);
        ATT_RESCALE(); ATT_TAIL(0);
    }
    int i = 1;
    for (; i + 1 < NT; i += 2) { ATT_ITER(pB0, pB1, pA0, pA1, i); ATT_ITER(pA0, pA1, pB0, pB1, i + 1); }
    if (i < NT) {
        ATT_ITER(pB0, pB1, pA0, pA1, i);
        float sacc = 0.f;
#pragma unroll
        for (int q = 0; q < 8; ++q) { sacc += EL(pB0, pB1, 4 * q) + EL(pB0, pB1, 4 * q + 1); sacc += EL(pB0, pB1, 4 * q + 2) + EL(pB0, pB1, 4 * q + 3);
            pw[2 * q] = cvt_pk_bf16(EL(pB0, pB1, 4 * q), EL(pB0, pB1, 4 * q + 1)); pw[2 * q + 1] = cvt_pk_bf16(EL(pB0, pB1, 4 * q + 2), EL(pB0, pB1, 4 * q + 3)); }
        l += sacc;
    } else {
        float sacc = 0.f;
#pragma unroll
        for (int q = 0; q < 8; ++q) { sacc += EL(pA0, pA1, 4 * q) + EL(pA0, pA1, 4 * q + 1); sacc += EL(pA0, pA1, 4 * q + 2) + EL(pA0, pA1, 4 * q + 3);
            pw[2 * q] = cvt_pk_bf16(EL(pA0, pA1, 4 * q), EL(pA0, pA1, 4 * q + 1)); pw[2 * q + 1] = cvt_pk_bf16(EL(pA0, pA1, 4 * q + 2), EL(pA0, pA1, 4 * q + 3)); }
        l += sacc;
    }
    { ldsp Vp_ = lds + ATT_VOFF + vprev * ATT_VB; SB(); ATT_PVX(pA0, pA1, Vp_, false); }
    __syncthreads();
#undef SB
#undef ATT_LOAD
#undef ATT_STORE
#undef ATT_VLOAD
#undef ATT_KLOAD
#undef EL
#undef ATT_QK
#undef PAF
#undef ATT_MAX
#undef ATT_EXP
#undef ATT_PVX
#undef ATT_RESCALE
#undef ATT_TAIL
#undef ATT_ITER
}
template <int ND>
__device__ __forceinline__ void attn_normalize(ldsp lds, f32x16 (&o)[ND], float l) {
    const int tid = ltid(), lane = tid & 63, r32 = lane & 31, hi = lane >> 5, wid = tid >> 6;
    volatile LAS float* wsf = (volatile LAS float*)(lds + ATT_WSF) + wid * 64;
    const float lt = l + __shfl_xor(l, 32);
    if (hi == 0) wsf[r32] = 1.0f / lt;
#pragma unroll
    for (int r = 0; r < 16; ++r) { const float a = wsf[crow(r, hi)];
#pragma unroll
        for (int d = 0; d < ND; ++d) o[d][r] *= a; }
}
__device__ __forceinline__ void load_q(bf16x8 (&qr)[4], const bf16_t* Qp  ) {
    const int lane = ltid() & 63, hi = lane >> 5;
#pragma unroll
    for (int d0 = 0; d0 < 4; ++d0) qr[d0] = *(const bf16x8*)(Qp + d0 * 16 + hi * 8);
}

__device__ __forceinline__ void mixb_unit(ldsp lds, const bf16_t* P, const bf16_t* PT, float* stash, bf16_t* mix, const float* subg, float lam, float lam_init,
                                          int b, int h, int qrow0, bool ctx_only) {
    const int tid = ltid(), lane = tid & 63, r32 = lane & 31, hi = lane >> 5, wid = tid >> 6;
    const int rowq = qrow0 + 32 * wid;
    f32x16 o[4];
#pragma unroll 1
    for (int c = 0; c < 2; ++c) {
        bf16x8 qr[4];
        load_q(qr, P + (size_t)(rowq + r32) * PW + PC_QB + 128 * h + 64 * c);
        AttnSeg S;
        S.Kc = P + (size_t)(NLAT + b * CTXL) * PW + PC_KB + 128 * h + 64 * c;
        S.Kl = P + (size_t)(b * SEQ) * PW + PC_KB + 128 * h + 64 * c;
        S.Vc = PT + (size_t)(PR_VB + 128 * h) * MTOT + NLAT + b * CTXL;
        S.Vl = PT + (size_t)(PR_VB + 128 * h) * MTOT + b * SEQ;
        S.nctx = 4; S.t0 = 0; S.t1 = ctx_only ? 0 : (SEQ / 64);
#pragma unroll
        for (int d = 0; d < 4; ++d)
#pragma unroll
            for (int r = 0; r < 16; ++r) o[d][r] = 0.f;
        float m = -1e30f, l = 0.f;
        attn_pass<128, false>(lds, S, qr, 0, o, m, l);
        attn_normalize<4>(lds, o, l);
        if (c == 0) {
            int rq = rowq * 512 + h * 128 + r32 + 4 * hi * 512; asm volatile("" : "+v"(rq));
            float* sp = stash + rq;
#pragma unroll
            for (int d = 0; d < 4; ++d)
#pragma unroll
                for (int r = 0; r < 16; ++r) sp[((r & 3) + 8 * (r >> 2)) * 512 + 32 * d] = o[d][r];
        }
    }
    float gv[4];
#pragma unroll
    for (int d = 0; d < 4; ++d) gv[d] = subg[32 * d + r32] * (1.0f - lam_init);
    int rq2 = rowq + 4 * hi; asm volatile("" : "+v"(rq2));
    const float* sp2 = stash + (size_t)rq2 * 512 + h * 128 + r32;
    bf16_t* mp2 = mix + (size_t)rq2 * DM + 256 + 128 * h + r32;
    float ss[16];
#pragma unroll
    for (int r = 0; r < 16; ++r) {
        const int ro = (r & 3) + 8 * (r >> 2);
        float s = 0.f;
#pragma unroll
        for (int d = 0; d < 4; ++d) { o[d][r] = sp2[ro * 512 + 32 * d] - lam * o[d][r]; s += o[d][r] * o[d][r]; }
        ss[r] = s;
    }
#pragma unroll
    for (int st = 1; st < 32; st <<= 1) {
#pragma unroll
        for (int r = 0; r < 16; ++r) ss[r] += __shfl_xor(ss[r], st);
    }
#pragma unroll
    for (int r = 0; r < 16; ++r) {
        const int ro = (r & 3) + 8 * (r >> 2);
        const float rstd = rsqrtf(ss[r] * (1.0f / 128.0f) + EPS);
#pragma unroll
        for (int d = 0; d < 4; ++d) { const float y = o[d][r] * rstd * gv[d]; mp2[ro * DM + 32 * d] = (bf16_t)(cvt_pk_bf16(y, 0.f) & 0xffffu); }
    }
}
__device__ __forceinline__ void mixa_unit(ldsp lds, const bf16_t* P, const bf16_t* PT, bf16_t* mix, float sink, int b, int qh, int qrow0, int q0  , bool ctx_only) {
    const int tid = ltid(), lane = tid & 63, r32 = lane & 31, hi = lane >> 5, wid = tid >> 6;
    const int rowq = qrow0 + 32 * wid; const int g = qh >> 1;
    bf16x8 qr[4];
    load_q(qr, P + (size_t)(rowq + r32) * PW + PC_QA + 64 * qh);
    AttnSeg S;
    S.Kc = P + (size_t)(NLAT + b * CTXL) * PW + PC_KA + 64 * g;
    S.Kl = P + (size_t)(b * SEQ) * PW + PC_KA + 64 * g;
    S.Vc = PT + (size_t)(PR_VA + 64 * g) * MTOT + NLAT + b * CTXL;
    S.Vl = PT + (size_t)(PR_VA + 64 * g) * MTOT + b * SEQ;
    S.nctx = 4;
    if (ctx_only) { S.t0 = 0; S.t1 = 0; }
    else { const int lo = q0 - 128, hi_ = q0 + 256 + 128; S.t0 = (lo < 0 ? 0 : lo) / 64; S.t1 = (hi_ > SEQ ? SEQ : hi_) / 64; }
    f32x16 o[2];
#pragma unroll
    for (int d = 0; d < 2; ++d)
#pragma unroll
        for (int r = 0; r < 16; ++r) o[d][r] = 0.f;
    float m = sink * LOG2E, l = (hi == 0) ? 1.0f : 0.0f;
    attn_pass<64, true>(lds, S, qr, q0 + 32 * wid + r32, o, m, l);
    attn_normalize<2>(lds, o, l);
#pragma unroll
    for (int r = 0; r < 16; ++r) { const size_t row = (size_t)(rowq + crow(r, hi));
#pragma unroll
        for (int d = 0; d < 2; ++d) mix[row * DM + 64 * qh + 32 * d + r32] = (bf16_t)(cvt_pk_bf16(o[d][r], 0.f) & 0xffffu); }
}
__device__ __forceinline__ int chunk_row(int b, int cc) { return cc < 2 ? NLAT + b * CTXL + 128 * cc : b * SEQ + 128 * (cc - 2); }
__device__ __forceinline__ void r1_unit(const bf16_t* P, const bf16_t* PT, float* KV, const float* lg, int b, int h, int cc) {
    const int lane = ltid() & 63, r32 = lane & 31, hi = lane >> 5;
    const int tok0 = chunk_row(b, cc);
    const float lgf = lg[h], lgb = lg[4 + h];
    f32x16 of[2], ob[2];
#pragma unroll
    for (int d = 0; d < 2; ++d)
#pragma unroll
        for (int r = 0; r < 16; ++r) { of[d][r] = 0.f; ob[d][r] = 0.f; }
#pragma unroll 4
    for (int kb = 0; kb < 8; ++kb) {
        float kf[8], kk[8];
#pragma unroll
        for (int i = 0; i < 8; ++i) {
            const int key = 16 * kb + 8 * hi + i;
            const float kv = bf2f(P[(size_t)(tok0 + key) * PW + PC_KR + 32 * h + r32]);
            kf[i] = kv * __builtin_amdgcn_exp2f(lgf * (float)(127 - key));
            kk[i] = kv * __builtin_amdgcn_exp2f(lgb * (float)key);
        }
        u32x4 wf, wb;
        wf.x = cvt_pk_bf16(kf[0], kf[1]); wf.y = cvt_pk_bf16(kf[2], kf[3]); wf.z = cvt_pk_bf16(kf[4], kf[5]); wf.w = cvt_pk_bf16(kf[6], kf[7]);
        wb.x = cvt_pk_bf16(kk[0], kk[1]); wb.y = cvt_pk_bf16(kk[2], kk[3]); wb.z = cvt_pk_bf16(kk[4], kk[5]); wb.w = cvt_pk_bf16(kk[6], kk[7]);
        const bf16x8 bfv = __builtin_bit_cast(bf16x8, wf), bbv = __builtin_bit_cast(bf16x8, wb);
#pragma unroll
        for (int d = 0; d < 2; ++d) {
            const bf16x8 av = *(const bf16x8*)(PT + (size_t)(PR_VR + 64 * h + 32 * d + r32) * MTOT + tok0 + 16 * kb + 8 * hi);
            of[d] = MFMA32(av, bfv, of[d]); ob[d] = MFMA32(av, bbv, ob[d]);
        }
    }
    float* kvp = KV + ((size_t)((b * 4 + h) * NCH + cc) * 2) * 2048;
#pragma unroll
    for (int d = 0; d < 2; ++d)
#pragma unroll
        for (int r = 0; r < 16; ++r) { const int idx = (32 * d + crow(r, hi)) * 32 + r32; kvp[idx] = of[d][r]; kvp[2048 + idx] = ob[d][r]; }
}
__device__ __forceinline__ void r2_phase(const float* KV, float* ST, const float* lg, int G) {
    for (int t = lbid() * 512 + ltid(); t < 16 * 2 * 2048; t += G * 512) {
        const int e = t & 2047, dir = (t >> 11) & 1, bh = t >> 12, h = bh & 3;
        const float dc = __builtin_amdgcn_exp2f(lg[dir * 4 + h] * 128.0f);
        const float* kv = KV + (size_t)bh * NCH * 4096 + dir * 2048 + e;
        float* st = ST + (size_t)bh * NCH * 4096 + dir * 2048 + e;
        float s = 0.f;
#pragma unroll 1
        for (int g0 = 0; g0 < NCH; g0 += 33) {
            float kvv[33];
#pragma unroll
            for (int q = 0; q < 33; ++q) {
                const int sidx = g0 + q;
                const int cc = (dir == 0) ? sidx : ((sidx < 2) ? (1 - sidx) : (NCH + 1 - sidx));
                kvv[q] = kv[(size_t)cc * 4096];
            }
#pragma unroll
            for (int q = 0; q < 33; ++q) {
                const int sidx = g0 + q;
                const int cc = (dir == 0) ? sidx : ((sidx < 2) ? (1 - sidx) : (NCH + 1 - sidx));
                st[(size_t)cc * 4096] = s; s = dc * s + kvv[q];
            }
        }
    }
}
__device__ __forceinline__ bf16x8 scale_bf16x8(bf16x8 v, float s) {
    const u32x4 w = __builtin_bit_cast(u32x4, v); u32x4 o;
    o.x = cvt_pk_bf16(bflo(w.x) * s, bfhi(w.x) * s); o.y = cvt_pk_bf16(bflo(w.y) * s, bfhi(w.y) * s);
    o.z = cvt_pk_bf16(bflo(w.z) * s, bfhi(w.z) * s); o.w = cvt_pk_bf16(bflo(w.w) * s, bfhi(w.w) * s);
    return __builtin_bit_cast(bf16x8, o);
}
__device__ __forceinline__ void r3_unit(ldsp lds, const bf16_t* P, const bf16_t* PT, const float* ST, bf16_t* mix, const float* lg, int b, int h, int blk, bool is_ctx) {
    const int tid = ltid(), lane = tid & 63, r32 = lane & 31, hi = lane >> 5, wid = tid >> 6;
    const int cw = 2 * blk + (wid >> 2), cc = is_ctx ? cw : cw + 2, i0 = 32 * (wid & 3);
    const int tok0 = chunk_row(b, cc);
    const float lgf = lg[h], lgb = lg[4 + h];
    constexpr int R3_KS = 80, R3_KC = 128 * R3_KS, R3_VS = 272, R3_VC = 64 * R3_VS, R3_VOFF = 2 * R3_KC;
    {
        const int cc0 = is_ctx ? 2 * blk : 2 * blk + 2;
        u32x4 kreg[2], vreg[4];
#pragma unroll
        for (int j = 0; j < 2; ++j) { const int p = tid + 512 * j, ch = p >> 9, row = (p >> 2) & 127, part = p & 3;
            kreg[j] = *(const u32x4*)(P + (size_t)(chunk_row(b, cc0 + ch) + row) * PW + PC_KR + 32 * h + part * 8); }
#pragma unroll
        for (int j = 0; j < 4; ++j) { const int p = tid + 512 * j, ch = p >> 10, row = (p >> 4) & 63, part = p & 15;
            vreg[j] = *(const u32x4*)(PT + (size_t)(PR_VR + 64 * h + row) * MTOT + chunk_row(b, cc0 + ch) + part * 8); }
#pragma unroll
        for (int j = 0; j < 2; ++j) { const int p = tid + 512 * j, ch = p >> 9, row = (p >> 2) & 127, part = p & 3;
            *(LAS u32x4*)(lds + ch * R3_KC + row * R3_KS + part * 16) = kreg[j]; }
#pragma unroll
        for (int j = 0; j < 4; ++j) { const int p = tid + 512 * j, ch = p >> 10, row = (p >> 4) & 63, part = p & 15;
            *(LAS u32x4*)(lds + R3_VOFF + ch * R3_VC + row * R3_VS + part * 16) = vreg[j]; }
    }
    __syncthreads();
    ldsp Kl = lds + (wid >> 2) * R3_KC; ldsp Vl = lds + R3_VOFF + (wid >> 2) * R3_VC;
    bf16x8 q2[2];
#pragma unroll
    for (int d0 = 0; d0 < 2; ++d0) q2[d0] = *(const bf16x8*)(P + (size_t)(tok0 + i0 + r32) * PW + PC_QR + 32 * h + 16 * d0 + 8 * hi);
    f32x16 o[2];
#pragma unroll
    for (int d = 0; d < 2; ++d)
#pragma unroll
        for (int r = 0; r < 16; ++r) o[d][r] = 0.f;
    const int qi = i0 + r32;
#pragma unroll 2
    for (int kb = 0; kb < 4; ++kb) {
        f32x16 p;
#pragma unroll
        for (int r = 0; r < 16; ++r) p[r] = 0.f;
#pragma unroll
        for (int d0 = 0; d0 < 2; ++d0) {
            const bf16x8 kf = *(const LAS bf16x8*)(Kl + (32 * kb + r32) * R3_KS + (16 * d0 + 8 * hi) * 2);
            p = MFMA32(kf, q2[d0], p);
        }
#pragma unroll
        for (int r = 0; r < 16; ++r) {
            const int dlt = qi - (32 * kb + crow(r, hi));
            const float w = dlt >= 0 ? __builtin_amdgcn_exp2f(lgf * (float)dlt) : __builtin_amdgcn_exp2f(lgb * (float)(-dlt));
            p[r] *= w;
        }
        u32x4 w0, w1;
        w0.x = cvt_pk_bf16(p[0], p[1]); w0.y = cvt_pk_bf16(p[2], p[3]); w0.z = cvt_pk_bf16(p[4], p[5]); w0.w = cvt_pk_bf16(p[6], p[7]);
        w1.x = cvt_pk_bf16(p[8], p[9]); w1.y = cvt_pk_bf16(p[10], p[11]); w1.z = cvt_pk_bf16(p[12], p[13]); w1.w = cvt_pk_bf16(p[14], p[15]);
        const bf16x8 pa0 = __builtin_bit_cast(bf16x8, w0), pa1 = __builtin_bit_cast(bf16x8, w1);
#pragma unroll
        for (int d = 0; d < 2; ++d)
#pragma unroll
            for (int jj = 0; jj < 2; ++jj) {
                ldsp vp = Vl + (32 * d + r32) * R3_VS + (32 * kb + 16 * jj + 4 * hi) * 2;
                const s16x4 lo = *(const LAS s16x4*)(vp), h4 = *(const LAS s16x4*)(vp + 16);
                const bf16x8 vf = (bf16x8){lo[0], lo[1], lo[2], lo[3], h4[0], h4[1], h4[2], h4[3]};
                o[d] = MFMA32(jj == 0 ? pa0 : pa1, vf, o[d]);
            }
    }
#pragma unroll
    for (int dir = 0; dir < 2; ++dir) {
        const float s = dir == 0 ? __builtin_amdgcn_exp2f(lgf * (float)(qi + 1)) : __builtin_amdgcn_exp2f(lgb * (float)(128 - qi));
        const float* stp = ST + ((size_t)((b * 4 + h) * NCH + cc) * 2 + dir) * 2048;
#pragma unroll
        for (int d0 = 0; d0 < 2; ++d0) {
            const bf16x8 qs = scale_bf16x8(q2[d0], s);
#pragma unroll
            for (int d = 0; d < 2; ++d) {
                const float* sp = stp + (32 * d + r32) * 32 + 16 * d0 + 8 * hi;
                const f32x4 a = *(const f32x4*)(sp), c = *(const f32x4*)(sp + 4);
                u32x4 w; w.x = cvt_pk_bf16(a[0], a[1]); w.y = cvt_pk_bf16(a[2], a[3]); w.z = cvt_pk_bf16(c[0], c[1]); w.w = cvt_pk_bf16(c[2], c[3]);
                o[d] = MFMA32(qs, __builtin_bit_cast(bf16x8, w), o[d]);
            }
        }
    }
    float s1[16], q1[16];
#pragma unroll
    for (int r = 0; r < 16; ++r) s1[r] = o[0][r] + o[1][r];
#pragma unroll
    for (int st = 1; st < 32; st <<= 1) {
#pragma unroll
        for (int r = 0; r < 16; ++r) s1[r] += __shfl_xor(s1[r], st);
    }
#pragma unroll
    for (int r = 0; r < 16; ++r) { const float mean = s1[r] * (1.0f / 64.0f); o[0][r] -= mean; o[1][r] -= mean; q1[r] = o[0][r] * o[0][r] + o[1][r] * o[1][r]; }
#pragma unroll
    for (int st = 1; st < 32; st <<= 1) {
#pragma unroll
        for (int r = 0; r < 16; ++r) q1[r] += __shfl_xor(q1[r], st);
    }
    float gg0[16], gg1[16];
    {
        const bf16_t* gp0; const bf16_t* gp1; size_t gstride;
        if (h < 2) { gp0 = P + (size_t)(tok0 + i0 + 4 * hi) * PW + PC_GR + 64 * h + r32; gp1 = gp0 + 32; gstride = PW; }
        else { gp0 = PT + (size_t)(PR_GR2 + 64 * (h - 2) + r32) * MTOT + tok0 + i0 + 4 * hi; gp1 = gp0 + (size_t)32 * MTOT; gstride = 1; }
#pragma unroll
        for (int r = 0; r < 16; ++r) { const size_t ro = (size_t)((r & 3) + 8 * (r >> 2)) * gstride; gg0[r] = bf2f(gp0[ro]); gg1[r] = bf2f(gp1[ro]); }
    }
#pragma unroll
    for (int r = 0; r < 16; ++r) {
        const float rstd = rsqrtf(q1[r] * (1.0f / 64.0f) + EPS);
        const size_t row = (size_t)(tok0 + i0 + crow(r, hi));
        mix[row * DM + 768 + 64 * h + r32] = (bf16_t)(cvt_pk_bf16(silu_f(gg0[r]) * o[0][r] * rstd, 0.f) & 0xffffu);
        mix[row * DM + 768 + 64 * h + 32 + r32] = (bf16_t)(cvt_pk_bf16(silu_f(gg1[r]) * o[1][r] * rstd, 0.f) & 0xffffu);
    }
    __syncthreads();
}

#ifndef PH_PREP
#define PH_PREP 1
#endif
#ifndef PH_NORM
#define PH_NORM 1
#endif
#ifndef PH_IN1
#define PH_IN1 1
#endif
#ifndef PH_IN2
#define PH_IN2 1
#endif
#ifndef PH_R1
#define PH_R1 1
#endif
#ifndef PH_R2
#define PH_R2 1
#endif
#ifndef PH_MIX
#define PH_MIX 1
#endif
#ifndef PH_OUT
#define PH_OUT 1
#endif
#ifndef PH_UP
#define PH_UP 1
#endif
#ifndef PH_CONV
#define PH_CONV 1
#endif
#ifndef PH_DOWN
#define PH_DOWN 1
#endif
#ifndef PH_FIN
#define PH_FIN 1
#endif
__device__ __forceinline__ void mix_phase(ldsp lds, KArgs a, int l, int G) {
    unsigned char* ws = a->ws;
    const bf16_t* P = (const bf16_t*)(ws + WS_P); const bf16_t* PT = (const bf16_t*)(ws + WS_PT);
    bf16_t* mix = (bf16_t*)(ws + WS_MIX); float* stash = a->out;
    const float* ST = (const float*)(ws + WS_ST);
    const float* scal = (const float*)(ws + WS_SCAL);
    const float lam = scal[l], lam_init = scal[2 + l];
    const float* lg = scal + 8 + l * 8;
    const int nc = (l == 0) ? 16 : 0;
    const int total = 3 * (512 + nc);
    for (int u = lbid(); u < total; u += G) {
        int v = u; int kind = 0;
        if (v >= 512 + nc) { v -= 512 + nc; kind = 1; if (v >= 512 + nc) { v -= 512 + nc; kind = 2; } }
        const bool ctx = v >= 512; if (ctx) v -= 512;
        int b, hh, qb;
        if (ctx) { b = v >> 2; hh = v & 3; qb = 0; }
        else {
            int vv = v;
            if (G == 256) { const int x = v & 7, y = (v >> 3) & 31, rnd = v >> 8; vv = (x + 8 * rnd) * 32 + y; }
            b = vv >> 7; hh = (vv >> 5) & 3; qb = vv & 31;
        }
        const int qrow0 = ctx ? NLAT + b * CTXL : b * SEQ + qb * 256;
#ifndef NO_MB
        if (kind == 0) mixb_unit(lds, P, PT, stash, mix, a->in[I_SUBG] + l * 128, lam, lam_init, b, hh, qrow0, ctx);
#endif
#ifndef NO_MA
        if (kind == 1) mixa_unit(lds, P, PT, mix, a->in[I_SINK][l * 4 + hh], b, hh, qrow0, qb * 256, ctx);
#endif
#ifndef NO_MR
        if (kind == 2) r3_unit(lds, P, PT, ST, mix, lg, b, hh, qb, ctx);
#endif
    }
}


enum { K_PREP = 0, K_NORM1, K_GEMM_IN, K_GEMM_PT, K_R1, K_R2, K_MIX, K_GEMM_OUT, K_NORM2, K_UP, K_DOWN, K_FINAL };
constexpr int NPH_L = 10, NPH = 2 + 2 * NPH_L;
__global__ void __launch_bounds__(512, 2) fwd_megakernel(Args a_unused) {
    extern __shared__ __attribute__((aligned(16))) unsigned char lds_raw[];
    ldsp lds = (ldsp)lds_raw;
    cg::grid_group grid = cg::this_grid();
    const int G = gridDim.x;
    {
        volatile LAS unsigned* st = (volatile LAS unsigned*)(lds + LDS_ST_OFF);
        if (ltid() < 2) st[ltid()] = 0u;
        __syncthreads();
        KArgs a0 = (KArgs)__builtin_amdgcn_kernarg_segment_ptr();
        (void)xcd_barrier_post((unsigned*)(a0->ws + WS_BAR), st);
    }
    if (PH_PREP) {
        KArgs a0 = (KArgs)__builtin_amdgcn_kernarg_segment_ptr();
        asm volatile("" : "+s"(a0));
        prep_phase(a0, lds, G);
        if (G > (1 << 20)) grid.sync();
        { XcdBarrier xb; xb.bar = (unsigned*)(a0->ws + WS_BAR); xb.x = xb_xcc_id(); xb.st = (volatile LAS unsigned*)(lds + LDS_ST_OFF); xcd_barrier(xb); }
    }
#pragma unroll 1
    for (int ph = 1; ph < NPH; ++ph) {
        int kind, l;
        if (ph == 0) { kind = K_PREP; l = 0; } else if (ph == NPH - 1) { kind = K_FINAL; l = 1; } else { l = (ph - 1) / NPH_L; kind = K_NORM1 + (ph - 1) % NPH_L; }
        KArgs a = (KArgs)__builtin_amdgcn_kernarg_segment_ptr();
        asm volatile("" : "+s"(a));
        unsigned char* ws = a->ws;
        float* modv = (float*)(ws + WS_MOD);
        const float* modl = modv + (size_t)l * 5 * NMOD;
        bf16_t* Xb = (bf16_t*)(ws + WS_XBF);
        bf16_t* H = (bf16_t*)(ws + WS_H);
        const bool last = (l == 1);
        const int Mffn = last ? NLAT : MTOT;
        const float* xin_l = (l == 0) ? a->in[I_X] : nullptr; const float* xin_c = (l == 0) ? a->in[I_CTX] : nullptr;
        bool sync = true;
        if (PH_NORM && (kind == K_NORM1 || kind == K_NORM2)) {
            const bool n1 = kind == K_NORM1;
            norm_phase(n1 ? xin_l : nullptr, n1 ? xin_c : nullptr, Xb, a->in[n1 ? I_N1G : I_N2G] + l * DM, modl, n1 ? 0 : 3, n1 ? 1 : 4, H, n1 ? MTOT : Mffn, G);
        } else if (PH_IN1 && kind == K_GEMM_IN) {
            const float* c64 = (const float*)(ws + WS_ROPE); const float* s64 = c64 + SEQ * 32; const float* c32 = s64 + SEQ * 32; const float* s32 = c32 + SEQ * 16;
            const bf16_t* Wt_in = (const bf16_t*)(ws + WS_WIN) + (size_t)l * 3072 * DM;
            pg8::Gemm g{H, Wt_in, MTOT, PW, DM}; pg8::StaticOrder S; S.init(MTOT, PW, G, lbid());
            EpiInTok E{(bf16_t*)(ws + WS_P), c64, s64, c32, s32};
            pg8::gemm_phase<EpiInTok, pg8::StaticOrder, true, true>(lds, g, S, E);
            sync = false;
        } else if (PH_UP && kind == K_GEMM_PT) {
            const bf16_t* Wt_in = (const bf16_t*)(ws + WS_WIN) + (size_t)l * 3072 * DM;
            pg8::Gemm g{Wt_in + (size_t)PW * DM, H, PTR, MTOT, DM}; EpiStoreBf16 E{(bf16_t*)(ws + WS_PT), MTOT};
            pg8::StaticOrder S; S.init(g.M, g.N, G, (lbid() + G - ((MTOT / 256) * (PW / 256)) % G) % G);
            pg8::gemm_phase<EpiStoreBf16, pg8::StaticOrder, true, true>(lds, g, S, E);
        } else if (PH_UP && kind == K_UP) {
            const bf16_t* Wt_up = (const bf16_t*)(ws + WS_WUP) + (size_t)l * NUP * DM;
            const int ntile = (Mffn + 247) / 248;
            pg8::Gemm g{H - DM, Wt_up, ntile * 256, NUP, DM};
            EpiUpConv E{(bf16_t*)(ws + WS_A), (const float*)(ws + WS_CWP) + (size_t)l * DFF * 8, Mffn};
            pg8::StaticOrder S; S.init(g.M, g.N, G, lbid());
            pg8::gemm_phase<EpiUpConv, pg8::StaticOrder, true, true>(lds, g, S, E);
        } else if (PH_R1 && kind == K_R1) {
            const int gw = lbid() * 8 + (ltid() >> 6), NGW = G * 8;
            const float* lg = (const float*)(ws + WS_SCAL) + 8 + l * 8;
            for (int u = gw; u < 16 * NCH; u += NGW) { const int bh = u / NCH, cc = u % NCH; r1_unit((const bf16_t*)(ws + WS_P), (const bf16_t*)(ws + WS_PT), (float*)(ws + WS_KV), lg, bh >> 2, bh & 3, cc); }
        } else if (PH_R2 && kind == K_R2) {
            r2_phase((const float*)(ws + WS_KV), (float*)(ws + WS_ST), (const float*)(ws + WS_SCAL) + 8 + l * 8, G);
        } else if (PH_MIX && kind == K_MIX) {
            mix_phase(lds, a, l, G);
        } else if (PH_OUT && (kind == K_GEMM_OUT || kind == K_DOWN)) {
            pg8::Gemm g; EpiResid E;
            if (kind == K_GEMM_OUT) {
                g = pg8::Gemm{(const bf16_t*)(ws + WS_MIX), (const bf16_t*)(ws + WS_WOUT) + (size_t)l * DM * DM, Mffn, DM, DM};
                E = EpiResid{xin_l, xin_c, Xb, modl + 2 * DM};
            } else {
                g = pg8::Gemm{(const bf16_t*)(ws + WS_A), (const bf16_t*)(ws + WS_WDN) + (size_t)l * DM * DFF, Mffn, DM, DFF};
                E = EpiResid{nullptr, nullptr, Xb, modl + 5 * DM};
            }
            pg8::StaticOrder S; S.init(g.M, g.N, G, lbid());
            pg8::gemm_phase<EpiResid, pg8::StaticOrder, true, true>(lds, g, S, E);
        } else if (PH_FIN && kind == K_FINAL) {
            final_norm_phase(Xb, a->out, a->in[I_FG], G);
            sync = false;
        }
        if (sync) { XcdBarrier xb; xb.bar = (unsigned*)(ws + WS_BAR); xb.x = xb_xcc_id(); xb.st = (volatile LAS unsigned*)(lds + LDS_ST_OFF); xcd_barrier(xb); }
    }
}

extern "C" void kernel_launch(void* const* d_in, const int* in_sizes, int n_in, void* d_out, int out_size, void* d_ws, size_t ws_size, hipStream_t stream) {
    static int grid = 0;
    if (grid == 0) {
        if (n_in != 19 || out_size != NLAT * DM || ws_size < WS_END) { fprintf(stderr, "kernel_launch: unexpected shapes: n_in %d out %d ws %zu (need %zu)\n", n_in, out_size, ws_size, (size_t)WS_END); grid = -1; return; }
        int dev = 0, cus = 0, per_cu = 0;
        if (hipGetDevice(&dev) != hipSuccess || hipDeviceGetAttribute(&cus, hipDeviceAttributeMultiprocessorCount, dev) != hipSuccess) { grid = -1; return; }
        if (hipFuncSetAttribute((const void*)fwd_megakernel, hipFuncAttributeMaxDynamicSharedMemorySize, LDS_BYTES) != hipSuccess) { fprintf(stderr, "kernel_launch: hipFuncSetAttribute failed\n"); grid = -1; return; }
        if (hipOccupancyMaxActiveBlocksPerMultiprocessor(&per_cu, (const void*)fwd_megakernel, 512, LDS_BYTES) != hipSuccess || per_cu < 1) { fprintf(stderr, "kernel_launch: occupancy query says %d\n", per_cu); per_cu = 1; }
        (void)hipGetLastError();
        grid = cus;
    }
    if (grid < 0) return;
    if (hipMemsetAsync((char*)d_ws + WS_BAR, 0, 16384, stream) != hipSuccess) { fprintf(stderr, "memset failed\n"); return; }
    Args a{};
    for (int i = 0; i < 19; ++i) a.in[i] = (const float*)d_in[i];
    a.out = (float*)d_out; a.ws = (unsigned char*)d_ws;
    void* args[] = {&a};
    hipError_t e = hipLaunchCooperativeKernel((const void*)fwd_megakernel, dim3(grid), dim3(512), args, LDS_BYTES, stream);
    if (e != hipSuccess) fprintf(stderr, "cooperative launch failed: %s (grid %d)\n", hipGetErrorString(e), grid);
}
```
